# Optimizing an MI355X kernel written in HIP

```python
import math
import jax, jax.numpy as jnp
from jax import lax
import numpy as np

D_MODEL = 2048
BATCH = 2
SEQ = 8192
DEPTH = 4

N_MIXERS = 3
N_LAYERS_A = (DEPTH + 2) // 3
N_LAYERS_B = (DEPTH + 1) // 3
N_LAYERS_C = DEPTH // 3
HEAD_DIM = 128
D_FF = 5632
RMS_EPS = 1e-6
Q_BLOCK = 128
A_HEADS = D_MODEL // (2 * HEAD_DIM)
A_VDIM = 2 * HEAD_DIM
B_HEADS = D_MODEL // HEAD_DIM
GRID_W = 64
NA_ROWS = 8
NA_COLS = 16
C_HEADS = D_MODEL // HEAD_DIM
C_KV_HEADS = 4
C_GROUP = C_HEADS // C_KV_HEADS
C_WINDOW = 128

kernel_name = "hybrid_macaron_diffattn_natten_swa_encoder"


def rms_norm(x, g):
    x32 = x.astype(jnp.float32)
    y = x32 * lax.rsqrt(jnp.mean(x32 * x32, axis=-1, keepdims=True) + RMS_EPS)
    return (y * g.astype(jnp.float32)).astype(x.dtype)


def swiglu(x, w_gate, w_up, w_down):
    return (jax.nn.silu(x @ w_gate) * (x @ w_up)) @ w_down


def alibi_slopes(n_heads):
    return jnp.asarray(2.0 ** (-8.0 * np.arange(1, n_heads + 1) / n_heads), dtype=jnp.float32)


def diff_attention(h, w_qkv, q_gain, k_gain, lq1, lk1, lq2, lk2, subln_g, w_o, lambda_init):
    B, S, _ = h.shape
    qk_w = A_HEADS * 2 * HEAD_DIM
    q, k, v = jnp.split(h @ w_qkv, [qk_w, 2 * qk_w], axis=-1)
    q = rms_norm(q.reshape(B, S, A_HEADS, 2, HEAD_DIM), q_gain)
    k = rms_norm(k.reshape(B, S, A_HEADS, 2, HEAD_DIM), k_gain)
    v = v.reshape(B, S, A_HEADS, A_VDIM)
    lam = (jnp.exp(jnp.sum(lq1.astype(jnp.float32) * lk1.astype(jnp.float32)))
           - jnp.exp(jnp.sum(lq2.astype(jnp.float32) * lk2.astype(jnp.float32))) + lambda_init)
    slopes = alibi_slopes(A_HEADS)
    pos = jnp.arange(S)
    n_blk = S // Q_BLOCK
    scale = HEAD_DIM ** -0.5
    q_blocks = q.reshape(B, n_blk, Q_BLOCK, A_HEADS, 2, HEAD_DIM).transpose(1, 0, 2, 3, 4, 5)

    def one_block(args):
        qb, t0 = args
        t = t0 + jnp.arange(Q_BLOCK)
        dist = jnp.abs(t[:, None] - pos[None, :]).astype(jnp.float32)
        s = (jnp.einsum('bqhcd,bkhcd->bhcqk', qb, k).astype(jnp.float32) * scale
             - slopes[:, None, None, None] * dist)
        p = jax.nn.softmax(s, axis=-1)
        a = p[:, :, 0] - lam * p[:, :, 1]
        return jnp.einsum('bhqk,bkhe->bqhe', a.astype(v.dtype), v)

    o = lax.map(one_block, (q_blocks, jnp.arange(n_blk) * Q_BLOCK))
    o = o.transpose(1, 0, 2, 3, 4).reshape(B, S, A_HEADS, A_VDIM)
    o = rms_norm(o, subln_g) * (1.0 - lambda_init)
    return o.reshape(B, S, A_HEADS * A_VDIM) @ w_o


def neighbourhood_attention(h, w_qkv, q_gain, k_gain, rel_bias, w_o):
    B, S, _ = h.shape
    rows = S // GRID_W
    kr = min(NA_ROWS, rows)
    kc = NA_COLS
    q, k, v = jnp.split(h @ w_qkv, 3, axis=-1)
    q = rms_norm(q.reshape(B, rows, GRID_W, B_HEADS, HEAD_DIM), q_gain)
    k = rms_norm(k.reshape(B, rows, GRID_W, B_HEADS, HEAD_DIM), k_gain)
    v = v.reshape(B, rows, GRID_W, B_HEADS, HEAD_DIM)
    cols = np.arange(GRID_W)
    c_start = np.clip(cols - kc // 2, 0, GRID_W - kc)
    col_idx = c_start[:, None] + np.arange(kc)
    dcol = col_idx - cols[:, None] + (NA_COLS - 1)
    bias_cols = rel_bias[:, :, dcol]
    scale = HEAD_DIM ** -0.5

    def one_row(r):
        r_start = jnp.clip(r - kr // 2, 0, rows - kr)
        k_win = lax.dynamic_slice_in_dim(k, r_start, kr, axis=1)[:, :, col_idx]
        v_win = lax.dynamic_slice_in_dim(v, r_start, kr, axis=1)[:, :, col_idx]
        q_r = lax.dynamic_index_in_dim(q, r, axis=1, keepdims=False)
        drow = r_start + jnp.arange(kr) - r + (NA_ROWS - 1)
        bias = jnp.take(bias_cols, drow, axis=1).transpose(0, 2, 1, 3)
        s = (jnp.einsum('bchd,brckhd->bhcrk', q_r, k_win).astype(jnp.float32) * scale
             + bias[None].astype(jnp.float32))
        p = jax.nn.softmax(s.reshape(B, B_HEADS, GRID_W, kr * kc), axis=-1)
        p = p.reshape(B, B_HEADS, GRID_W, kr, kc)
        return jnp.einsum('bhcrk,brckhd->bchd', p.astype(v.dtype), v_win)

    o = lax.map(one_row, jnp.arange(rows))
    o = o.transpose(1, 0, 2, 3, 4).reshape(B, S, B_HEADS * HEAD_DIM)
    return o @ w_o


def window_gqa(h, w_qkv, q_gain, k_gain, sink, w_o):
    B, S, _ = h.shape
    q_w = C_HEADS * HEAD_DIM
    kv_w = C_KV_HEADS * HEAD_DIM
    q, k, v = jnp.split(h @ w_qkv, [q_w, q_w + kv_w], axis=-1)
    n_blk = S // Q_BLOCK
    q = rms_norm(q.reshape(B, n_blk, Q_BLOCK, C_KV_HEADS, C_GROUP, HEAD_DIM), q_gain)
    k = rms_norm(k.reshape(B, S, C_KV_HEADS, HEAD_DIM), k_gain)
    v = v.reshape(B, S, C_KV_HEADS, HEAD_DIM)
    pad = ((0, 0), (Q_BLOCK, Q_BLOCK), (0, 0), (0, 0))
    kp = jnp.pad(k, pad).reshape(B, n_blk + 2, Q_BLOCK, C_KV_HEADS, HEAD_DIM)
    vp = jnp.pad(v, pad).reshape(B, n_blk + 2, Q_BLOCK, C_KV_HEADS, HEAD_DIM)
    k_band = jnp.concatenate([kp[:, :-2], kp[:, 1:-1], kp[:, 2:]], axis=2)
    v_band = jnp.concatenate([vp[:, :-2], vp[:, 1:-1], vp[:, 2:]], axis=2)
    blk0 = jnp.arange(n_blk)[:, None] * Q_BLOCK
    t = blk0 + jnp.arange(Q_BLOCK)
    s_pos = blk0 - Q_BLOCK + jnp.arange(3 * Q_BLOCK)
    dist = jnp.abs(t[:, :, None] - s_pos[:, None, :])
    valid = (dist <= C_WINDOW) & (s_pos[:, None, :] >= 0) & (s_pos[:, None, :] < S)
    slopes = alibi_slopes(C_HEADS).reshape(C_KV_HEADS, C_GROUP)
    scale = HEAD_DIM ** -0.5
    s = (jnp.einsum('bnqkgd,bnskd->bkgnqs', q, k_band).astype(jnp.float32) * scale
         - slopes[:, :, None, None, None] * dist.astype(jnp.float32))
    s = jnp.where(valid, s, -jnp.inf)
    sink_l = jnp.broadcast_to(sink.astype(jnp.float32).reshape(C_KV_HEADS, C_GROUP)[None, :, :, None, None, None],
                              s.shape[:-1] + (1,))
    p = jax.nn.softmax(jnp.concatenate([s, sink_l], axis=-1), axis=-1)[..., :-1]
    o = jnp.einsum('bkgnqs,bnskd->bnqkgd', p.astype(v.dtype), v_band)
    return o.reshape(B, S, C_HEADS * HEAD_DIM) @ w_o


def setup_inputs(seed: int = 0) -> dict:
    key = jax.random.key(seed)
    keys = iter(jax.random.split(key, 40))
    f32 = jnp.float32

    def w(shape, fan_in):
        return jax.random.normal(next(keys), shape, f32) * (fan_in ** -0.5)

    def gain(shape):
        return 1.0 + 0.02 * jax.random.normal(next(keys), shape, f32)

    def small(shape, s):
        return s * jax.random.normal(next(keys), shape, f32)

    return {
        "x": jax.random.normal(next(keys), (BATCH, SEQ, D_MODEL), f32),
        "norm_ffn1": gain((DEPTH, D_MODEL)),
        "ffn1_w_gate": w((DEPTH, D_MODEL, D_FF), D_MODEL),
        "ffn1_w_up": w((DEPTH, D_MODEL, D_FF), D_MODEL),
        "ffn1_w_down": w((DEPTH, D_FF, D_MODEL), D_FF),
        "norm_mix": gain((DEPTH, D_MODEL)),
        "norm_ffn2": gain((DEPTH, D_MODEL)),
        "ffn2_w_gate": w((DEPTH, D_MODEL, D_FF), D_MODEL),
        "ffn2_w_up": w((DEPTH, D_MODEL, D_FF), D_MODEL),
        "ffn2_w_down": w((DEPTH, D_FF, D_MODEL), D_FF),
        "a_w_qkv": w((N_LAYERS_A, D_MODEL, 2 * A_HEADS * 2 * HEAD_DIM + A_HEADS * A_VDIM), D_MODEL),
        "a_q_norm": gain((N_LAYERS_A, HEAD_DIM)),
        "a_k_norm": gain((N_LAYERS_A, HEAD_DIM)),
        "a_lambda_q1": small((N_LAYERS_A, HEAD_DIM), 0.1),
        "a_lambda_k1": small((N_LAYERS_A, HEAD_DIM), 0.1),
        "a_lambda_q2": small((N_LAYERS_A, HEAD_DIM), 0.1),
        "a_lambda_k2": small((N_LAYERS_A, HEAD_DIM), 0.1),
        "a_subln": gain((N_LAYERS_A, A_VDIM)),
        "a_w_o": w((N_LAYERS_A, A_HEADS * A_VDIM, D_MODEL), A_HEADS * A_VDIM),
        "b_w_qkv": w((N_LAYERS_B, D_MODEL, 3 * B_HEADS * HEAD_DIM), D_MODEL),
        "b_q_norm": gain((N_LAYERS_B, HEAD_DIM)),
        "b_k_norm": gain((N_LAYERS_B, HEAD_DIM)),
        "b_rel_bias": small((N_LAYERS_B, B_HEADS, 2 * NA_ROWS - 1, 2 * NA_COLS - 1), 0.5),
        "b_w_o": w((N_LAYERS_B, B_HEADS * HEAD_DIM, D_MODEL), B_HEADS * HEAD_DIM),
        "c_w_qkv": w((N_LAYERS_C, D_MODEL, (C_HEADS + 2 * C_KV_HEADS) * HEAD_DIM), D_MODEL),
        "c_q_norm": gain((N_LAYERS_C, HEAD_DIM)),
        "c_k_norm": gain((N_LAYERS_C, HEAD_DIM)),
        "c_sink": small((N_LAYERS_C, C_HEADS), 1.0),
        "c_w_o": w((N_LAYERS_C, C_HEADS * HEAD_DIM, D_MODEL), C_HEADS * HEAD_DIM),
    }


def reference(x, norm_ffn1, ffn1_w_gate, ffn1_w_up, ffn1_w_down, norm_mix, norm_ffn2,
              ffn2_w_gate, ffn2_w_up, ffn2_w_down,
              a_w_qkv, a_q_norm, a_k_norm, a_lambda_q1, a_lambda_k1, a_lambda_q2, a_lambda_k2,
              a_subln, a_w_o,
              b_w_qkv, b_q_norm, b_k_norm, b_rel_bias, b_w_o,
              c_w_qkv, c_q_norm, c_k_norm, c_sink, c_w_o):
    for i in range(DEPTH):
        x = x + 0.5 * swiglu(rms_norm(x, norm_ffn1[i]), ffn1_w_gate[i], ffn1_w_up[i], ffn1_w_down[i])
        h = rms_norm(x, norm_mix[i])
        kind, j = i % N_MIXERS, i // N_MIXERS
        if kind == 0:
            lambda_init = 0.8 - 0.6 * math.exp(-0.3 * i)
            y = diff_attention(h, a_w_qkv[j], a_q_norm[j], a_k_norm[j], a_lambda_q1[j], a_lambda_k1[j],
                               a_lambda_q2[j], a_lambda_k2[j], a_subln[j], a_w_o[j], lambda_init)
        elif kind == 1:
            y = neighbourhood_attention(h, b_w_qkv[j], b_q_norm[j], b_k_norm[j], b_rel_bias[j], b_w_o[j])
        else:
            y = window_gqa(h, c_w_qkv[j], c_q_norm[j], c_k_norm[j], c_sink[j], c_w_o[j])
        x = x + y
        x = x + 0.5 * swiglu(rms_norm(x, norm_ffn2[i]), ffn2_w_gate[i], ffn2_w_up[i], ffn2_w_down[i])
    return x
```

```cpp
#include <hip/hip_runtime.h>
#include <hip/hip_bf16.h>
#include <cstdio>
#include <cstdint>
#include <cmath>
__device__ __forceinline__ int tid_fresh() { int t = threadIdx.x; asm volatile("" : "+v"(t)); return t; }
namespace pg8 {
#define PG8_LAS __attribute__((address_space(3)))
typedef unsigned short bf16_t;
typedef short bf16x8 __attribute__((ext_vector_type(8)));
typedef float f32x4 __attribute__((ext_vector_type(4)));
typedef unsigned u32x4 __attribute__((ext_vector_type(4)));
constexpr int BM = 256, BK = 64, HALF = 128, HTB = HALF * BK * 2  , STAGE_BYTES = 8 * HTB, NXCD = 8, WGM = 8;

__host__ __device__ __forceinline__ int lds_byte(int r, int c) { const int st = (r >> 4) * 2 + (c >> 5), rr = r & 15, cc = c & 31, ob = rr * 64 + cc * 2; return st * 1024 + (ob ^ (((ob >> 9) & 1) << 5)); }
__host__ __device__ __forceinline__ void stage_rc(int b, int& R, int& C) { const int st = b / 1024, sb = b % 1024, swz = sb ^ (((sb >> 9) & 1) << 5); R = (st >> 1) * 16 + swz / 64; C = (st & 1) * 32 + (swz % 64) / 2; }
__host__ __device__ __forceinline__ int perm32(int rho) { const int n = rho >> 4, i = rho & 15; return 8 * (i >> 2) + 4 * n + (i & 3); }

struct Unit { int pm, pn; };
struct Gemm { const bf16_t* A; const bf16_t* Bt; int M, N, K, lda, ldb; };

struct StaticOrder {
    int nM, nN, nwg, G, c;
    __host__ __device__ void init(int M, int N, int G_, int c_) { nM = M / BM; nN = N / BM; nwg = nM * nN; G = G_; c = c_; }
    __host__ __device__ bool next(int i, Unit& u) const {
        const long L = (long)i * G + c; if (L >= nwg) return false;
        int wgid = (int)L; { const int q = nwg / NXCD, r = nwg % NXCD, xcd = wgid % NXCD, off = wgid / NXCD; wgid = (xcd < r ? xcd * (q + 1) : r * (q + 1) + (xcd - r) * q) + off; }
        const int nig = WGM * nN, gid = wgid / nig, fm = gid * WGM, gsz = (nM - fm) < WGM ? (nM - fm) : WGM;
        u.pm = fm + ((wgid % nig) % gsz); u.pn = (wgid % nig) / gsz; return true;
    }
    __device__ __forceinline__ void a_ready(const Unit&) const {}
    __device__ __forceinline__ void done(const Unit&) const {}
};


__device__ __forceinline__ unsigned cvt_pk_bf16(float lo, float hi) { unsigned r; asm volatile("v_cvt_pk_bf16_f32 %0, %1, %2" : "=v"(r) : "v"(lo), "v"(hi)); return r; }

constexpr float PG8_EPS = 1e-6f;
struct RstdPanel {
    const float* rowss; PG8_LAS float* tab; volatile PG8_LAS int* tag;
    __device__ __forceinline__ void ensure(int pm, int tid) const {
        const int have = __builtin_amdgcn_readfirstlane(*tag);
        if (have != pm) {
            asm volatile("s_waitcnt lgkmcnt(0)" ::: "memory"); __builtin_amdgcn_s_barrier(); asm volatile("" ::: "memory");
            if (tid < BM) { const f32x4* p = (const f32x4*)(rowss + (size_t)(pm * BM + tid) * 32); f32x4 v[8];
#pragma unroll
                for (int i = 0; i < 8; ++i) v[i] = p[i];
                float s = 0.f;
#pragma unroll
                for (int i = 0; i < 8; ++i) s += (v[i][0] + v[i][1]) + (v[i][2] + v[i][3]);
                tab[tid] = 1.0f / sqrtf(s * (1.0f / 2048.0f) + PG8_EPS); }
            if (tid == 0) *tag = pm;
            asm volatile("s_waitcnt lgkmcnt(0)" ::: "memory"); __builtin_amdgcn_s_barrier(); asm volatile("" ::: "memory");
        }
    }
    __device__ __forceinline__ void rows(int wr, int fr, float (&rs)[2][4]) const {
#pragma unroll
        for (int ai = 0; ai < 2; ++ai)
#pragma unroll
            for (int m = 0; m < 4; ++m) rs[ai][m] = tab[ai * HALF + wr * 64 + m * 16 + fr];
    }
};

struct EpiQKV {
    static constexpr bool PERM = true, AFTER_DRAIN = false;
    bf16_t* O; int ldc; RstdPanel rp; const float* gq; const float* gk; int nk; PG8_LAS float* P;
    __device__ __forceinline__ void operator()(const f32x4 (&acc)[2][2][4][2], const Unit& u, int wr, int wc, int fr, int fq) const {
        const int row0 = u.pm * BM + wr * 64 + fr, col0 = u.pn * BM + wc * 32 + 8 * fq;
        float rs[2][4]; rp.ensure(u.pm, (wr * 4 + wc) * 64 + fq * 16 + fr); rp.rows(wr, fr, rs);
        const int cls = u.pn < 8 ? 0 : (u.pn < 8 + (nk >> 1) ? 1 : 2);
        if (cls == 2) {
#pragma unroll
            for (int ai = 0; ai < 2; ++ai)
#pragma unroll
                for (int m = 0; m < 4; ++m) { bf16_t* rowp = O + (size_t)(row0 + ai * HALF + m * 16) * ldc + col0; const float r = rs[ai][m];
#pragma unroll
                    for (int bj = 0; bj < 2; ++bj) { const f32x4 v0 = acc[ai][bj][m][0] * r, v1 = acc[ai][bj][m][1] * r;
                        u32x4 w; w.x = cvt_pk_bf16(v0[0], v0[1]); w.y = cvt_pk_bf16(v0[2], v0[3]); w.z = cvt_pk_bf16(v1[0], v1[1]); w.w = cvt_pk_bf16(v1[2], v1[3]);
                        *(u32x4*)(rowp + bj * HALF) = w; } }
        } else {
            const float* g = cls == 0 ? gq : gk;
            const f32x4 g0 = *(const f32x4*)(g + wc * 32 + 8 * fq), g1 = *(const f32x4*)(g + wc * 32 + 8 * fq + 4);
#pragma unroll
            for (int ai = 0; ai < 2; ++ai)
#pragma unroll
                for (int m = 0; m < 4; ++m) { const float r = rs[ai][m];
#pragma unroll
                    for (int bj = 0; bj < 2; ++bj) { const f32x4 v0 = acc[ai][bj][m][0] * r, v1 = acc[ai][bj][m][1] * r;
                        float s = ((v0[0] * v0[0] + v0[1] * v0[1]) + (v0[2] * v0[2] + v0[3] * v0[3])) + ((v1[0] * v1[0] + v1[1] * v1[1]) + (v1[2] * v1[2] + v1[3] * v1[3]));
                        s += __shfl_xor(s, 16); s += __shfl_xor(s, 32);
                        if (fq == 0) P[((ai * HALF + wr * 64 + m * 16 + fr) * 2 + bj) * 4 + wc] = s; } }
            asm volatile("s_waitcnt lgkmcnt(0)" ::: "memory"); __builtin_amdgcn_s_barrier(); asm volatile("" ::: "memory");
#pragma unroll
            for (int ai = 0; ai < 2; ++ai)
#pragma unroll
                for (int m = 0; m < 4; ++m) { bf16_t* rowp = O + (size_t)(row0 + ai * HALF + m * 16) * ldc + col0; const float r = rs[ai][m];
#pragma unroll
                    for (int bj = 0; bj < 2; ++bj) { const f32x4 t = *(const PG8_LAS f32x4*)(P + ((ai * HALF + wr * 64 + m * 16 + fr) * 2 + bj) * 4);
                        const float rn = r / sqrtf(((t[0] + t[1]) + (t[2] + t[3])) * (1.0f / 128.0f) + PG8_EPS);
                        const f32x4 v0 = acc[ai][bj][m][0] * rn * g0, v1 = acc[ai][bj][m][1] * rn * g1;
                        u32x4 w; w.x = cvt_pk_bf16(v0[0], v0[1]); w.y = cvt_pk_bf16(v0[2], v0[3]); w.z = cvt_pk_bf16(v1[0], v1[1]); w.w = cvt_pk_bf16(v1[2], v1[3]);
                        *(u32x4*)(rowp + bj * HALF) = w; } }
        }
    }
};
__device__ __forceinline__ float silu_mul(float g, float u) { const float e = __builtin_amdgcn_exp2f(g * -1.4426950408889634f); return g * __builtin_amdgcn_rcpf(1.0f + e) * u; }
struct EpiSwiGLU {
    static constexpr bool PERM = true, AFTER_DRAIN = false;
    bf16_t* O; int ldc; RstdPanel rp;
    __device__ __forceinline__ void operator()(const f32x4 (&acc)[2][2][4][2], const Unit& u, int wr, int wc, int fr, int fq) const {
        const int row0 = u.pm * BM + wr * 64 + fr, col0 = u.pn * HALF + wc * 32 + 8 * fq;
        float rs[2][4]; rp.ensure(u.pm, (wr * 4 + wc) * 64 + fq * 16 + fr); rp.rows(wr, fr, rs);
#pragma unroll
        for (int ai = 0; ai < 2; ++ai)
#pragma unroll
            for (int m = 0; m < 4; ++m) { bf16_t* rowp = O + (size_t)(row0 + ai * HALF + m * 16) * ldc + col0; const float r = rs[ai][m];
                const f32x4 g0 = acc[ai][0][m][0] * r, g1 = acc[ai][0][m][1] * r, u0 = acc[ai][1][m][0] * r, u1 = acc[ai][1][m][1] * r;
                u32x4 w; w.x = cvt_pk_bf16(silu_mul(g0[0], u0[0]), silu_mul(g0[1], u0[1])); w.y = cvt_pk_bf16(silu_mul(g0[2], u0[2]), silu_mul(g0[3], u0[3]));
                w.z = cvt_pk_bf16(silu_mul(g1[0], u1[0]), silu_mul(g1[1], u1[1])); w.w = cvt_pk_bf16(silu_mul(g1[2], u1[2]), silu_mul(g1[3], u1[3]));
                *(u32x4*)rowp = w; }
    }
};
struct EpiResid {
    static constexpr bool PERM = true, AFTER_DRAIN = false;
    const float* base32; const bf16_t* xin; bf16_t* xb; float* out32; float* rowss; int ldc, ld32; float alpha;
    __device__ __forceinline__ void operator()(const f32x4 (&acc)[2][2][4][2], const Unit& u, int wr, int wc, int fr, int fq) const {
        const int row0 = u.pm * BM + wr * 64 + fr, col0 = u.pn * BM + wc * 32 + 8 * fq;
#pragma unroll
        for (int ai = 0; ai < 2; ++ai)
#pragma unroll
            for (int m = 0; m < 4; ++m) { const int row = row0 + ai * HALF + m * 16; const size_t off = (size_t)row * ldc + col0, off32 = (size_t)row * ld32 + col0; float ss = 0.f;
#pragma unroll
                for (int bj = 0; bj < 2; ++bj) { f32x4 b0, b1;
                    if (base32) { b0 = *(const f32x4*)(base32 + off32 + bj * HALF); b1 = *(const f32x4*)(base32 + off32 + bj * HALF + 4); }
                    else { const u32x4 w = *(const u32x4*)(xin + off + bj * HALF);
                        b0 = (f32x4){__uint_as_float(w.x << 16), __uint_as_float(w.x & 0xffff0000u), __uint_as_float(w.y << 16), __uint_as_float(w.y & 0xffff0000u)};
                        b1 = (f32x4){__uint_as_float(w.z << 16), __uint_as_float(w.z & 0xffff0000u), __uint_as_float(w.w << 16), __uint_as_float(w.w & 0xffff0000u)}; }
                    const f32x4 o0 = b0 + acc[ai][bj][m][0] * alpha, o1 = b1 + acc[ai][bj][m][1] * alpha;
                    u32x4 w; w.x = cvt_pk_bf16(o0[0], o0[1]); w.y = cvt_pk_bf16(o0[2], o0[3]); w.z = cvt_pk_bf16(o1[0], o1[1]); w.w = cvt_pk_bf16(o1[2], o1[3]);
                    if (xb) *(u32x4*)(xb + off + bj * HALF) = w;
                    if (out32) { *(f32x4*)(out32 + off32 + bj * HALF) = o0; *(f32x4*)(out32 + off32 + bj * HALF + 4) = o1; }
                    const float r0 = __uint_as_float(w.x << 16), r1 = __uint_as_float(w.x & 0xffff0000u), r2 = __uint_as_float(w.y << 16), r3 = __uint_as_float(w.y & 0xffff0000u);
                    const float r4 = __uint_as_float(w.z << 16), r5 = __uint_as_float(w.z & 0xffff0000u), r6 = __uint_as_float(w.w << 16), r7 = __uint_as_float(w.w & 0xffff0000u);
                    ss += ((r0 * r0 + r1 * r1) + (r2 * r2 + r3 * r3)) + ((r4 * r4 + r5 * r5) + (r6 * r6 + r7 * r7)); }
                if (rowss) { ss += __shfl_xor(ss, 16); ss += __shfl_xor(ss, 32); if (fq == 0) rowss[(size_t)row * 32 + u.pn * 4 + wc] = ss; }
                if (m & 1) asm volatile("" ::: "memory"); }
    }
};

template <class Epi, class Sched, bool ALIGN_EPI = false, bool SP2 = false>
__device__ __forceinline__ void gemm_phase(PG8_LAS unsigned char* lds, const Gemm g, const Sched& S, const Epi& E) {
    const int tid = tid_fresh(), wid = __builtin_amdgcn_readfirstlane(tid >> 6), lane = tid & 63, wr = wid >> 2, wc = wid & 3, fr = lane & 15, fq = lane >> 4;
    const int K = g.K, nt = K / BK;
    unsigned voffA[2], voffB[2];
#pragma unroll
    for (int i = 0; i < 2; ++i) { int R, C; stage_rc(tid * 16 + i * 8192, R, C); const int Rb = Epi::PERM ? ((R & ~31) + perm32(R & 31)) : R;
        voffA[i] = (unsigned)(R * g.lda + C) * 2u; voffB[i] = (unsigned)(Rb * g.ldb + C) * 2u; }
    const size_t kstep = (size_t)(BK * 2);
    const size_t hstepA = (size_t)HALF * g.lda * 2, hstepB = (size_t)HALF * g.ldb * 2;
    const size_t tstepA = 2 * hstepA, tstepB = 2 * hstepB;
    const unsigned ldsw = (unsigned)wid * 1024u;
    const int aoff = lds_byte(wr * 64 + fr, fq * 8), boff = lds_byte(wc * 32 + fr, fq * 8);
#define PG8_SA(b, h) (((b) * 2 + (h)) * HTB)
#define PG8_SB(b, h) ((4 + (b) * 2 + (h)) * HTB)
#define PG8_STAGE(bufoff, gbase, voff) do { _Pragma("unroll") for (int _i = 0; _i < 2; ++_i) \
        __builtin_amdgcn_global_load_lds((const unsigned*)((const char*)(gbase) + (voff)[_i]), (PG8_LAS unsigned*)(lds + (bufoff) + ldsw + _i * 8192), 16, 0, 0); } while (0)
#define PG8_LDA(dst, b, h) do { _Pragma("unroll") for (int m = 0; m < 4; ++m) _Pragma("unroll") for (int k = 0; k < 2; ++k) dst[m][k] = *(const PG8_LAS bf16x8*)(lds + PG8_SA(b, h) + aoff + m * 2048 + k * 1024); } while (0)
#define PG8_LDB(dst, b, h) do { _Pragma("unroll") for (int n = 0; n < 2; ++n) _Pragma("unroll") for (int k = 0; k < 2; ++k) dst[n][k] = *(const PG8_LAS bf16x8*)(lds + PG8_SB(b, h) + boff + n * 2048 + k * 1024); } while (0)
#define PG8_MMA(ai, bj, At, Bt) do { __builtin_amdgcn_s_setprio(1); _Pragma("unroll") for (int m = 0; m < 4; ++m) _Pragma("unroll") for (int n = 0; n < 2; ++n) _Pragma("unroll") for (int k = 0; k < 2; ++k) \
        acc[ai][bj][m][n] = __builtin_amdgcn_mfma_f32_16x16x32_bf16(Bt[n][k], At[m][k], acc[ai][bj][m][n], 0, 0, 0); __builtin_amdgcn_s_setprio(0); } while (0)
#define PG8_WAIT_V(n) asm volatile("s_waitcnt vmcnt(" #n ")" ::: "memory")
#define PG8_WAIT_L(n) asm volatile("s_waitcnt lgkmcnt(" #n ")" ::: "memory")
#define PG8_BAR __builtin_amdgcn_s_barrier()
#define PG8_SCHED __builtin_amdgcn_sched_barrier(0)
    Unit cur, nxt; int ui = 0;
    if (!S.next(0, cur)) return;
    f32x4 acc[2][2][4][2];
#pragma unroll
    for (int a = 0; a < 2; ++a)
#pragma unroll
        for (int b = 0; b < 2; ++b)
#pragma unroll
            for (int m = 0; m < 4; ++m)
#pragma unroll
                for (int n = 0; n < 2; ++n) acc[a][b][m][n] = (f32x4){0.f, 0.f, 0.f, 0.f};
    bf16x8 At[4][2], B0[2][2], B1[2][2];
    const char* cA = (const char*)g.A + (size_t)cur.pm * tstepA; const char* cB = (const char*)g.Bt + (size_t)cur.pn * tstepB;
    S.a_ready(cur);
    if constexpr (SP2) {
        PG8_STAGE(PG8_SB(0, 0), cB, voffB); PG8_STAGE(PG8_SB(0, 1), cB + hstepB, voffB); PG8_STAGE(PG8_SA(0, 0), cA, voffA); PG8_STAGE(PG8_SA(0, 1), cA + hstepA, voffA);
        if (wr == 1) PG8_BAR;
        PG8_WAIT_V(2); PG8_BAR;
        PG8_STAGE(PG8_SB(1, 0), cB + kstep, voffB); PG8_STAGE(PG8_SA(1, 0), cA + kstep, voffA); PG8_STAGE(PG8_SB(1, 1), cB + hstepB + kstep, voffB);
        PG8_WAIT_V(6); PG8_BAR;
    } else {
        PG8_STAGE(PG8_SB(0, 0), cB, voffB); PG8_STAGE(PG8_SA(0, 0), cA, voffA); PG8_STAGE(PG8_SB(0, 1), cB + hstepB, voffB); PG8_STAGE(PG8_SA(0, 1), cA + hstepA, voffA);
        if (wr == 1) PG8_BAR;
        PG8_WAIT_V(4); PG8_BAR;
        PG8_STAGE(PG8_SB(1, 0), cB + kstep, voffB); PG8_STAGE(PG8_SA(1, 0), cA + kstep, voffA); PG8_STAGE(PG8_SB(1, 1), cB + hstepB + kstep, voffB);
        PG8_WAIT_V(6); PG8_BAR;
    }
    for (;;) {
        const bool has_next = S.next(ui + 1, nxt);
        const char* nA = has_next ? (const char*)g.A + (size_t)nxt.pm * tstepA : cA; const char* nB = has_next ? (const char*)g.Bt + (size_t)nxt.pn * tstepB : cB;
        for (int t = 0; t < nt; t += 2) {
            const bool last = (t == nt - 2);
            const char* a1 = cA + (size_t)(t + 1) * kstep;
            const char* a2 = last ? nA : cA + (size_t)(t + 2) * kstep; const char* b2 = last ? nB : cB + (size_t)(t + 2) * kstep;
            const char* a3 = a2 + kstep; const char* b3 = b2 + kstep;
            if (last && has_next) S.a_ready(nxt);
            if constexpr (SP2) {
            PG8_LDB(B0, 0, 0); PG8_LDB(B1, 0, 1); PG8_SCHED; PG8_LDA(At, 0, 0); PG8_STAGE(PG8_SA(1, 1), a1 + hstepA, voffA);
            PG8_WAIT_V(8); PG8_WAIT_L(0); PG8_BAR; PG8_MMA(0, 0, At, B0); PG8_MMA(0, 1, At, B1); PG8_BAR; PG8_SCHED;
            PG8_LDA(At, 0, 1); PG8_STAGE(PG8_SB(0, 0), b2, voffB); PG8_STAGE(PG8_SB(0, 1), b2 + hstepB, voffB); PG8_STAGE(PG8_SA(0, 0), a2, voffA);
            PG8_WAIT_V(8); PG8_WAIT_L(0); PG8_BAR; PG8_MMA(1, 0, At, B0); PG8_MMA(1, 1, At, B1); PG8_BAR; PG8_SCHED;
            PG8_LDB(B0, 1, 0); PG8_LDB(B1, 1, 1); PG8_SCHED; PG8_LDA(At, 1, 0); PG8_STAGE(PG8_SA(0, 1), a2 + hstepA, voffA);
            PG8_WAIT_V(8); PG8_WAIT_L(0); PG8_BAR; PG8_MMA(0, 0, At, B0); PG8_MMA(0, 1, At, B1); PG8_BAR; PG8_SCHED;
            PG8_LDA(At, 1, 1); PG8_STAGE(PG8_SB(1, 0), b3, voffB); PG8_STAGE(PG8_SB(1, 1), b3 + hstepB, voffB); PG8_STAGE(PG8_SA(1, 0), a3, voffA);
            PG8_WAIT_V(8); PG8_WAIT_L(0); PG8_BAR; PG8_MMA(1, 0, At, B0); PG8_MMA(1, 1, At, B1); PG8_BAR; PG8_SCHED;
            } else {
            PG8_LDB(B0, 0, 0); PG8_SCHED; PG8_LDA(At, 0, 0); PG8_STAGE(PG8_SA(1, 1), a1 + hstepA, voffA);
            PG8_WAIT_L(8); PG8_BAR; PG8_WAIT_L(0); PG8_MMA(0, 0, At, B0); PG8_BAR; PG8_SCHED;
            PG8_LDB(B1, 0, 1); PG8_STAGE(PG8_SB(0, 0), b2, voffB);
            PG8_BAR; PG8_WAIT_L(0); PG8_MMA(0, 1, At, B1); PG8_BAR;
            PG8_LDA(At, 0, 1); PG8_STAGE(PG8_SA(0, 0), a2, voffA);
            PG8_BAR; PG8_WAIT_L(0); PG8_MMA(1, 0, At, B0); PG8_BAR; PG8_SCHED;
            PG8_STAGE(PG8_SB(0, 1), b2 + hstepB, voffB);
            PG8_WAIT_V(6); PG8_BAR; PG8_MMA(1, 1, At, B1); PG8_BAR;
            PG8_LDB(B0, 1, 0); PG8_SCHED; PG8_LDA(At, 1, 0); PG8_STAGE(PG8_SA(0, 1), a2 + hstepA, voffA);
            PG8_WAIT_L(8); PG8_BAR; PG8_WAIT_L(0); PG8_MMA(0, 0, At, B0); PG8_BAR; PG8_SCHED;
            PG8_LDB(B1, 1, 1); PG8_STAGE(PG8_SB(1, 0), b3, voffB);
            PG8_BAR; PG8_WAIT_L(0); PG8_MMA(0, 1, At, B1); PG8_BAR;
            PG8_LDA(At, 1, 1); PG8_STAGE(PG8_SA(1, 0), a3, voffA);
            PG8_BAR; PG8_WAIT_L(0); PG8_MMA(1, 0, At, B0); PG8_BAR; PG8_SCHED;
            PG8_STAGE(PG8_SB(1, 1), b3 + hstepB, voffB);
            PG8_WAIT_V(6); PG8_BAR; PG8_MMA(1, 1, At, B1); PG8_BAR;
            }
        }
        if constexpr (ALIGN_EPI) { if (wr == 0) PG8_BAR; }
        if constexpr (!Epi::AFTER_DRAIN) { E(acc, cur, wr, wc, fr, fq); S.done(cur); }
        if (!has_next) break;
#pragma unroll
        for (int a = 0; a < 2; ++a)
#pragma unroll
            for (int b = 0; b < 2; ++b)
#pragma unroll
                for (int m = 0; m < 4; ++m)
#pragma unroll
                    for (int n = 0; n < 2; ++n) acc[a][b][m][n] = (f32x4){0.f, 0.f, 0.f, 0.f};
        cur = nxt; cA = nA; cB = nB; ++ui;
        if constexpr (ALIGN_EPI) { if (wr == 1) PG8_BAR; }
    }
    PG8_WAIT_V(0);
    if constexpr (!ALIGN_EPI) { if (wr == 0) PG8_BAR; }
    PG8_BAR;
    if constexpr (Epi::AFTER_DRAIN) { E.fused(acc, cur, wr, wc, fr, fq, lds, wid, lane); S.done(cur); }
#undef PG8_SA
#undef PG8_SB
#undef PG8_STAGE
#undef PG8_LDA
#undef PG8_LDB
#undef PG8_MMA
#undef PG8_WAIT_V
#undef PG8_WAIT_L
#undef PG8_BAR
#undef PG8_SCHED
}
}
namespace att {
using bf16 = __hip_bfloat16;
using bf16x8 = __attribute__((ext_vector_type(8))) short;
using s16x4  = __attribute__((ext_vector_type(4))) short;
using f32x16 = __attribute__((ext_vector_type(16))) float;
using u32x4  = __attribute__((ext_vector_type(4))) unsigned;
constexpr int   D = 128, NW = 8, QBLK = 32, KVBLK = 64;
constexpr float SCALE = 0.088388347648318440f;
constexpr float ISCALE = 11.313708498984761f;
constexpr float THR = 8.f;
constexpr float NEG = -1e30f;
constexpr int TBL_FLOATS = 640;
#define KSWZ(row, colB) ((row) * 256 + ((colB) ^ (((row) & 7) << 4)))
#define SBAR() __builtin_amdgcn_sched_barrier(0)
__device__ __forceinline__ int crow(int r, int hi) { return (r & 3) + 8 * (r >> 2) + 4 * hi; }
__device__ __forceinline__ unsigned cvtpk(float lo, float hi) { unsigned r; asm volatile("v_cvt_pk_bf16_f32 %0, %1, %2" : "=v"(r) : "v"(lo), "v"(hi)); return r; }

__device__ __forceinline__ int v_rd_base(int lane) { return ((lane & 3) << 3) | (((lane >> 2) & 3) << 6) | (((lane >> 4) & 1) << 5) | (((lane >> 5) & 1) << 8); }
template <int OFF> __device__ __forceinline__ s16x4 tr_read(int vb) {
  s16x4 r; asm volatile("ds_read_b64_tr_b16 %0, %1 offset:%2" : "=&v"(r) : "v"(vb), "i"(OFF) : "memory"); return r;
}
constexpr int v_rd_off2(int ncb, int d0, int ks, int half) { return d0 * 512 + ks * (ncb * 1024) + half * (ncb * 512); }
template <int NCB> struct DmaGeo { static constexpr int KB = 16384, VB = 64 * NCB * 64, BUF = KB + VB, SCR = 2 * BUF, LDS_BYTES = SCR + NW * 256; };
constexpr int A_LDS_BYTES = DmaGeo<8>::LDS_BYTES, TBL2_OFF = DmaGeo<4>::LDS_BYTES;
template <int H> __device__ __forceinline__ void qk_half(f32x16& p, const char* Ks, const bf16x8* qr, int r32, int hi) {
  p = f32x16{};
#pragma unroll
  for (int d0 = 0; d0 < 8; ++d0) { const int cb = (d0 * 16 + hi * 8) * 2;
    const bf16x8 b = *reinterpret_cast<const bf16x8*>(Ks + KSWZ(32 * H + r32, cb));
    p = __builtin_amdgcn_mfma_f32_32x32x16_bf16(b, qr[d0], p, 0, 0, 0); }
}
__device__ __forceinline__ void sm_half(f32x16& p, float& m_reg, float& l_reg, float& alpha, bf16x8& paA, bf16x8& paB) {
  constexpr float C = SCALE * 1.4426950408889634f;
  float pmax = p[0];
#pragma unroll
  for (int r = 1; r < 16; ++r) pmax = fmaxf(pmax, p[r]);
  { auto rr = __builtin_amdgcn_permlane32_swap(__float_as_uint(pmax), __float_as_uint(pmax), false, false);
    pmax = fmaxf(__uint_as_float(rr[0]), __uint_as_float(rr[1])); }
  float mn;
  if (__builtin_expect(__all(pmax - m_reg <= THR / SCALE), 1)) { mn = m_reg; alpha = 1.f; }
  else { mn = fmaxf(m_reg, pmax); alpha = __builtin_amdgcn_exp2f((m_reg - mn) * C); m_reg = mn; }
  const float mnC = -mn * C;
#pragma unroll
  for (int r = 0; r < 16; ++r) p[r] = __builtin_amdgcn_exp2f(fmaf(p[r], C, mnC));
  float ps = 0;
#pragma unroll
  for (int r = 0; r < 16; ++r) ps += p[r];
  { auto rr = __builtin_amdgcn_permlane32_swap(__float_as_uint(ps), __float_as_uint(ps), false, false);
    ps = __uint_as_float(rr[0]) + __uint_as_float(rr[1]); }
  l_reg = l_reg * alpha + ps;
#define PK4(P, BASE, OUT) do { unsigned a0 = cvtpk(P[BASE + 0], P[BASE + 1]), a1 = cvtpk(P[BASE + 2], P[BASE + 3]);   \
    unsigned b0 = cvtpk(P[BASE + 4], P[BASE + 5]), b1 = cvtpk(P[BASE + 6], P[BASE + 7]);                              \
    auto r0 = __builtin_amdgcn_permlane32_swap(a0, b0, false, false); auto r1 = __builtin_amdgcn_permlane32_swap(a1, b1, false, false); \
    u32x4 w = {r0[0], r1[0], r0[1], r1[1]}; OUT = *reinterpret_cast<bf16x8*>(&w); } while (0)
  PK4(p, 0, paA); PK4(p, 8, paB);
#undef PK4
}
template <int NCB, int D0, int KS0> __device__ __forceinline__ void pv_pair(f32x16& oa, f32x16& ob, int vb, bf16x8 paA, bf16x8 paB) {
  const s16x4 al0 = tr_read<v_rd_off2(NCB, D0, KS0, 0)>(vb), ah0 = tr_read<v_rd_off2(NCB, D0, KS0, 1)>(vb), al1 = tr_read<v_rd_off2(NCB, D0, KS0 + 1, 0)>(vb), ah1 = tr_read<v_rd_off2(NCB, D0, KS0 + 1, 1)>(vb);
  const s16x4 bl0 = tr_read<v_rd_off2(NCB, D0 + 1, KS0, 0)>(vb), bh0 = tr_read<v_rd_off2(NCB, D0 + 1, KS0, 1)>(vb), bl1 = tr_read<v_rd_off2(NCB, D0 + 1, KS0 + 1, 0)>(vb), bh1 = tr_read<v_rd_off2(NCB, D0 + 1, KS0 + 1, 1)>(vb);
  asm volatile("s_waitcnt lgkmcnt(0)" ::: "memory"); SBAR();
#define PK(L, H) (bf16x8){L[0], L[1], L[2], L[3], H[0], H[1], H[2], H[3]}
  oa = __builtin_amdgcn_mfma_f32_32x32x16_bf16(PK(al0, ah0), paA, oa, 0, 0, 0);
  ob = __builtin_amdgcn_mfma_f32_32x32x16_bf16(PK(bl0, bh0), paA, ob, 0, 0, 0);
  oa = __builtin_amdgcn_mfma_f32_32x32x16_bf16(PK(al1, ah1), paB, oa, 0, 0, 0);
  ob = __builtin_amdgcn_mfma_f32_32x32x16_bf16(PK(bl1, bh1), paB, ob, 0, 0, 0);
#undef PK
}
template <int NCB, int KS0> __device__ __forceinline__ void pv_half(f32x16* o, int vb, bf16x8 paA, bf16x8 paB) {
  pv_pair<NCB, 0, KS0>(o[0], o[1], vb, paA, paB); pv_pair<NCB, 2, KS0>(o[2], o[3], vb, paA, paB);
  if constexpr (NCB == 8) { pv_pair<NCB, 4, KS0>(o[4], o[5], vb, paA, paB); pv_pair<NCB, 6, KS0>(o[6], o[7], vb, paA, paB); }
}
struct ModA2 {
  float slopeS; int qk0;
  template <int H> __device__ __forceinline__ bool skip(int) const { return false; }
  __device__ __forceinline__ float m_init() const { return -1e30f; }
  __device__ __forceinline__ float l_init() const { return 0.f; }
  template <int H> __device__ __forceinline__ void apply(f32x16& p, int jt) const {
    const float d0 = (float)(qk0 - jt * KVBLK - 32 * H), ns = -slopeS;
#pragma unroll
    for (int r = 0; r < 16; ++r) { const float c = (float)((r & 3) + 8 * (r >> 2)); p[r] = fmaf(ns, fabsf(d0 - c), p[r]); }
  }
};
struct ModC2 {
  float slopeS, sinkS; int qk0; int qw0;
  template <int H> __device__ __forceinline__ bool skip(int jt) const { const int d = qw0 - jt * KVBLK - 32 * H; return d > 128 + 31 || d < -(128 + 31); }
  __device__ __forceinline__ float m_init() const { return sinkS; }
  __device__ __forceinline__ float l_init() const { return 1.f; }
  template <int H> __device__ __forceinline__ void apply(f32x16& p, int jt) const {
    const float d0 = (float)(qk0 - jt * KVBLK - 32 * H), ns = -slopeS;
#pragma unroll
    for (int r = 0; r < 16; ++r) { const float c = (float)((r & 3) + 8 * (r >> 2)); const float e = fabsf(d0 - c); p[r] = e <= 128.f ? fmaf(ns, e, p[r]) : NEG; }
  }
};
struct ModB2 {
  const float* tbl;
  int r, r_start, kr0, tb0, kc0;
  int rs_u, cw0;
  template <int H> __device__ __forceinline__ bool skip(int jt) const { const int kr = kr0 + jt; if ((unsigned)(kr - rs_u) >= 8u) return true;
    const int lo = cw0 - 8 < 0 ? 0 : cw0 - 8, hi_ = (cw0 + 23 > 48 ? 48 : cw0 + 23) + 15; return 32 * H > hi_ || 32 * H + 31 < lo; }
  __device__ __forceinline__ float m_init() const { return -1e5f; }
  __device__ __forceinline__ float l_init() const { return 0.f; }
  template <int H> __device__ __forceinline__ void apply(f32x16& p, int jt) const {
    const int kr = kr0 + jt; const bool rowok = (unsigned)(kr - r_start) < 8u;
    int drow = kr - r + 7; drow = drow < 0 ? 0 : (drow > 14 ? 14 : drow);
    const float* tb = tbl + (tb0 + drow * 31 + 32 * H);
#pragma unroll
    for (int rr = 0; rr < 16; ++rr) { const int c = (rr & 3) + 8 * (rr >> 2);
      const bool ok = rowok && (unsigned)(c + 32 * H + kc0) < 16u; const float b = tb[c];
      p[rr] = ok ? p[rr] + b : NEG; }
  }
};
template <int NCB, int LDQ, int LDK, int LDO, class Mod>
__device__ __forceinline__ void attn_unit_dma(const bf16* __restrict__ Qb, const bf16* __restrict__ Kh, const bf16* __restrict__ Vh, bf16* __restrict__ Ob, int NT, const Mod& mod,
                                              __attribute__((address_space(3))) unsigned char* ldsl) {
  typedef __attribute__((address_space(3))) unsigned LU; typedef DmaGeo<NCB> G;
  const int tid = tid_fresh(), wid = __builtin_amdgcn_readfirstlane(tid >> 6), lane = tid & 63, r32 = lane & 31, hi = lane >> 5;
  char* lds = (char*)ldsl;
  float m_reg = mod.m_init(), l_reg = mod.l_init(); f32x16 o[NCB] = {}; bf16x8 qr[8];
  const bf16* Qw = Qb + (long)(wid * QBLK + r32) * LDQ + hi * 8;
#pragma unroll
  for (int d0 = 0; d0 < 8; ++d0) qr[d0] = *reinterpret_cast<const bf16x8*>(Qw + d0 * 16);
  const int krow = 4 * wid + (lane >> 4);
  const unsigned koff = (unsigned)(krow * LDK + (((lane & 15) ^ (krow & 7)) * 8)) * 2u;
  constexpr int PPK = NCB / 2, KSTEP = 64 / PPK;
  const int kk0 = (wid / PPK) * 8 + ((lane & 31) >> 2), vk0 = (kk0 & ~0xC) | ((kk0 & 4) << 1) | ((kk0 & 8) >> 1);
  const unsigned voff = (unsigned)(vk0 * LDK + ((2 * (wid % PPK) + (lane >> 5)) * 32 + (lane & 3) * 8)) * 2u;
  constexpr size_t TILE_B = (size_t)KVBLK * LDK * 2;
#define DMA_TILE(b, jt) do { const char* kg_ = (const char*)Kh + (size_t)(jt) * TILE_B; const char* vg_ = (const char*)Vh + (size_t)(jt) * TILE_B;                              \
    __builtin_amdgcn_global_load_lds((const unsigned*)(kg_ + koff), (LU*)(ldsl + (b) * G::BUF + wid * 1024), 16, 0, 0);                                                       \
    __builtin_amdgcn_global_load_lds((const unsigned*)(kg_ + koff + 32 * LDK * 2), (LU*)(ldsl + (b) * G::BUF + (wid + 8) * 1024), 16, 0, 0);                                  \
    _Pragma("unroll") for (int i_ = 0; i_ < PPK; ++i_)                                                                                                                        \
      __builtin_amdgcn_global_load_lds((const unsigned*)(vg_ + voff + i_ * KSTEP * LDK * 2), (LU*)(ldsl + (b) * G::BUF + G::KB + (wid + 8 * i_) * 1024), 16, 0, 0); } while (0)
#define TILE_SYNC() do { asm volatile("s_waitcnt vmcnt(0)" ::: "memory"); __syncthreads(); } while (0)
#define RESC(a) do { if (__any((a) < 1.f)) { asm volatile("; rescale (rare): keep this a real branch" ::: "memory"); \
    _Pragma("unroll") for (int d = 0; d < NCB; ++d) _Pragma("unroll") for (int r = 0; r < 16; ++r) o[d][r] *= (a); } } while (0)
  const int vbase = (int)(uintptr_t)(ldsl + G::KB) + v_rd_base(lane);
  DMA_TILE(0, 0); TILE_SYNC();
  for (int j = 0; j < NT; ++j) {
    const int b = j & 1;
    if (j + 1 < NT) DMA_TILE(b ^ 1, j + 1);
    const char* Ks = lds + b * G::BUF; const int vb = vbase + b * G::BUF;
    f32x16 p0, p1; float alpha; bf16x8 paA, paB;
    if (!mod.template skip<0>(j)) { qk_half<0>(p0, Ks, qr, r32, hi); mod.template apply<0>(p0, j); sm_half(p0, m_reg, l_reg, alpha, paA, paB); RESC(alpha); SBAR(); pv_half<NCB, 0>(o, vb, paA, paB); }
    if (!mod.template skip<1>(j)) { qk_half<1>(p1, Ks, qr, r32, hi); mod.template apply<1>(p1, j); sm_half(p1, m_reg, l_reg, alpha, paA, paB); RESC(alpha); SBAR(); pv_half<NCB, 2>(o, vb, paA, paB); }
    TILE_SYNC();
  }
  const float rl = __builtin_amdgcn_rcpf(l_reg);
  unsigned short* Orow = (unsigned short*)Ob + (long)(wid * QBLK + r32) * LDO + hi * 8;
#pragma unroll
  for (int d0 = 0; d0 < NCB; ++d0)
#pragma unroll
    for (int g = 0; g < 4; g += 2) {
      unsigned ax = cvtpk(o[d0][4 * g + 0] * rl, o[d0][4 * g + 1] * rl), ay = cvtpk(o[d0][4 * g + 2] * rl, o[d0][4 * g + 3] * rl);
      unsigned bx = cvtpk(o[d0][4 * g + 4] * rl, o[d0][4 * g + 5] * rl), by = cvtpk(o[d0][4 * g + 6] * rl, o[d0][4 * g + 7] * rl);
      auto rx = __builtin_amdgcn_permlane32_swap(ax, bx, false, false); auto ry = __builtin_amdgcn_permlane32_swap(ay, by, false, false);
      u32x4 w = {rx[0], ry[0], rx[1], ry[1]};
      *reinterpret_cast<u32x4*>(Orow + d0 * 32 + 8 * g) = w; }
#undef DMA_TILE
#undef TILE_SYNC
#undef RESC
}
template <int LDQ, int LDK, int LDO, class Mod>
__device__ __forceinline__ void attn_unit_dma_A(const bf16* __restrict__ Qb, const bf16* __restrict__ Kh, const bf16* __restrict__ Vh, bf16* __restrict__ Ob, int q0, int seq_tiles, float slope, float needC, const Mod& mod,
                                              __attribute__((address_space(3))) unsigned char* ldsl, volatile __attribute__((address_space(3))) float* red) {
  constexpr int NCB = 8;
  typedef __attribute__((address_space(3))) unsigned LU; typedef DmaGeo<NCB> G;
  const int tid = tid_fresh(), wid = __builtin_amdgcn_readfirstlane(tid >> 6), lane = tid & 63, r32 = lane & 31, hi = lane >> 5;
  char* lds = (char*)ldsl;
  float m_reg = mod.m_init(), l_reg = mod.l_init(); f32x16 o[NCB] = {}; bf16x8 qr[8];
  const bf16* Qw = Qb + (long)(wid * QBLK + r32) * LDQ + hi * 8;
#pragma unroll
  for (int d0 = 0; d0 < 8; ++d0) qr[d0] = *reinterpret_cast<const bf16x8*>(Qw + d0 * 16);
  const int krow = 4 * wid + (lane >> 4);
  const unsigned koff = (unsigned)(krow * LDK + (((lane & 15) ^ (krow & 7)) * 8)) * 2u;
  constexpr int PPK = NCB / 2, KSTEP = 64 / PPK;
  const int kk0 = (wid / PPK) * 8 + ((lane & 31) >> 2), vk0 = (kk0 & ~0xC) | ((kk0 & 4) << 1) | ((kk0 & 8) >> 1);
  const unsigned voff = (unsigned)(vk0 * LDK + ((2 * (wid % PPK) + (lane >> 5)) * 32 + (lane & 3) * 8)) * 2u;
  constexpr size_t TILE_B = (size_t)KVBLK * LDK * 2;
#define DMA_TILE(b, jt) do { const char* kg_ = (const char*)Kh + (size_t)(jt) * TILE_B; const char* vg_ = (const char*)Vh + (size_t)(jt) * TILE_B;                              \
    __builtin_amdgcn_global_load_lds((const unsigned*)(kg_ + koff), (LU*)(ldsl + (b) * G::BUF + wid * 1024), 16, 0, 0);                                                       \
    __builtin_amdgcn_global_load_lds((const unsigned*)(kg_ + koff + 32 * LDK * 2), (LU*)(ldsl + (b) * G::BUF + (wid + 8) * 1024), 16, 0, 0);                                  \
    _Pragma("unroll") for (int i_ = 0; i_ < PPK; ++i_)                                                                                                                        \
      __builtin_amdgcn_global_load_lds((const unsigned*)(vg_ + voff + i_ * KSTEP * LDK * 2), (LU*)(ldsl + (b) * G::BUF + G::KB + (wid + 8 * i_) * 1024), 16, 0, 0); } while (0)
#define TILE_SYNC() do { asm volatile("s_waitcnt vmcnt(0)" ::: "memory"); __syncthreads(); } while (0)
#define RESC(a) do { if (__any((a) < 1.f)) { asm volatile("; rescale (rare): keep this a real branch" ::: "memory"); \
    _Pragma("unroll") for (int d = 0; d < NCB; ++d) _Pragma("unroll") for (int r = 0; r < 16; ++r) o[d][r] *= (a); } } while (0)
  const int vbase = (int)(uintptr_t)(ldsl + G::KB) + v_rd_base(lane);
  const int tq = q0 >> 6;
  int c0 = tq - 1; c0 = c0 < 0 ? 0 : c0; int c1 = tq + 5; c1 = c1 > seq_tiles ? seq_tiles : c1;
  int L0 = 0, nL = 0, n = c1 - c0;
#define JT_(j) (seg == 0 ? c0 + (j) : ((j) < nL ? L0 + (j) : c1 + (j) - nL))
  for (int seg = 0; seg < 2; ++seg) {
    if (n > 0) {
      DMA_TILE(0, JT_(0)); TILE_SYNC();
      for (int j = 0; j < n; ++j) {
        const int b = j & 1;
        if (j + 1 < n) DMA_TILE(b ^ 1, JT_(j + 1));
        const int jt = JT_(j);
        const char* Ks = lds + b * G::BUF; const int vb = vbase + b * G::BUF;
        f32x16 p0, p1; float alpha; bf16x8 paA, paB;
        { qk_half<0>(p0, Ks, qr, r32, hi); mod.template apply<0>(p0, jt); sm_half(p0, m_reg, l_reg, alpha, paA, paB); RESC(alpha); SBAR(); pv_half<NCB, 0>(o, vb, paA, paB); }
        { qk_half<1>(p1, Ks, qr, r32, hi); mod.template apply<1>(p1, jt); sm_half(p1, m_reg, l_reg, alpha, paA, paB); RESC(alpha); SBAR(); pv_half<NCB, 2>(o, vb, paA, paB); }
        TILE_SYNC();
      }
    }
    if (seg == 0) {
      float lse = fmaf(m_reg, SCALE, __logf(l_reg));
#pragma unroll
      for (int o_ = 1; o_ < 64; o_ <<= 1) lse = fminf(lse, __shfl_xor(lse, o_));
      if (lane == 0) red[wid] = lse;
      __syncthreads();
      float lmin = red[0];
#pragma unroll
      for (int w_ = 1; w_ < 8; ++w_) lmin = fminf(lmin, red[w_]);
      __syncthreads();
      float d0f = (needC - lmin) / slope + 1.f; d0f = d0f < 0.f ? 0.f : d0f; const float smax = (float)(seq_tiles * 64);
      const int d0 = __builtin_amdgcn_readfirstlane(d0f > smax ? seq_tiles * 64 : (int)d0f);
      int klo = q0 - d0; klo = klo < 0 ? 0 : (klo >> 6);
      int khi = q0 + 256 + d0; khi = khi > seq_tiles * 64 ? seq_tiles : ((khi + 63) >> 6);
      L0 = klo; nL = c0 - klo; nL = nL < 0 ? 0 : nL;
      int nR = khi - c1; nR = nR < 0 ? 0 : nR;
      n = nL + nR;
    }
  }
#undef JT_
  const float rl = __builtin_amdgcn_rcpf(l_reg);
  unsigned short* Orow = (unsigned short*)Ob + (long)(wid * QBLK + r32) * LDO + hi * 8;
#pragma unroll
  for (int d0 = 0; d0 < NCB; ++d0)
#pragma unroll
    for (int g = 0; g < 4; g += 2) {
      unsigned ax = cvtpk(o[d0][4 * g + 0] * rl, o[d0][4 * g + 1] * rl), ay = cvtpk(o[d0][4 * g + 2] * rl, o[d0][4 * g + 3] * rl);
      unsigned bx = cvtpk(o[d0][4 * g + 4] * rl, o[d0][4 * g + 5] * rl), by = cvtpk(o[d0][4 * g + 6] * rl, o[d0][4 * g + 7] * rl);
      auto rx = __builtin_amdgcn_permlane32_swap(ax, bx, false, false); auto ry = __builtin_amdgcn_permlane32_swap(ay, by, false, false);
      u32x4 w = {rx[0], ry[0], rx[1], ry[1]};
      *reinterpret_cast<u32x4*>(Orow + d0 * 32 + 8 * g) = w; }
#undef DMA_TILE
#undef TILE_SYNC
#undef RESC
}
}
constexpr int NWAVES = 8;
constexpr int BATCH = 2, SEQ = 8192, DM = 2048, DFF = 5632, DEPTH = 4, HD = 128;
constexpr int M = BATCH * SEQ;
constexpr int LD2 = DM + 128, LDF = DFF + 128;
constexpr int LDQA = 6144 + 128, LDQC = 3072 + 128, LDOC = 4096 + 128;
constexpr int NGU = 2 * DFF;
constexpr float RMS_EPS = 1e-6f;
constexpr size_t MiB = 1u << 20;
constexpr size_t WS_CTL = 0, CTL_ZERO_BYTES = 1 * MiB;
constexpr size_t SZ_WGU = (size_t)NGU * LD2 * 2, SZ_WDN = (size_t)DM * LDF * 2, SZ_WQKV = (size_t)6144 * LD2 * 2, SZ_WO = (size_t)DM * LD2 * 2;
constexpr size_t WS_WGU = 2 * MiB;
constexpr size_t WS_WDN = WS_WGU + 8 * SZ_WGU;
constexpr size_t WS_WQKV = WS_WDN + 8 * SZ_WDN;
constexpr size_t WS_WO = WS_WQKV + 4 * SZ_WQKV;
constexpr size_t WS_H = WS_WO + 4 * SZ_WO;
constexpr size_t WS_ACT = WS_H + (size_t)M * LD2 * 2;
constexpr size_t WS_QKV = WS_ACT + (size_t)M * LDF * 2;
constexpr size_t WS_OC = WS_QKV + (size_t)M * LDQA * 2;
constexpr size_t WS_O = WS_OC + (size_t)M * LDOC * 2;
constexpr size_t WS_ROWSS = WS_O + (size_t)M * LD2 * 2;
constexpr size_t WS_END = WS_ROWSS + (size_t)12 * M * 32 * 4;
constexpr int CW_Q = 8192;
constexpr int CW_BAR = 4096;
constexpr int RING_OFF = 0, RING_BYTES = 131072;
constexpr int LDSCTL_OFF = RING_BYTES, MISC_OFF = LDSCTL_OFF + 320;
constexpr int RSTD_OFF = LDSCTL_OFF + 2048;
constexpr int QKN_OFF = LDSCTL_OFF + 4096;
constexpr int LDS_BYTES = 147456;
static_assert(att::A_LDS_BYTES <= RING_BYTES && att::TBL2_OFF + att::TBL_FLOATS * 4 <= RING_BYTES, "attention LDS inside the ring region");

#define GAS __attribute__((address_space(1)))
#define LAS __attribute__((address_space(3)))
typedef unsigned short bf16;
typedef unsigned v4u __attribute__((ext_vector_type(4)));
typedef unsigned v2u __attribute__((ext_vector_type(2)));
typedef float f32x4 __attribute__((ext_vector_type(4)));
typedef short bf16x8 __attribute__((ext_vector_type(8)));
#define LDS_WAIT() asm volatile("s_waitcnt lgkmcnt(0)" ::: "memory")
#define VM_WAIT() asm volatile("s_waitcnt vmcnt(0)" ::: "memory")
__device__ __forceinline__ unsigned pk2(float lo, float hi) { return pg8::cvt_pk_bf16(lo, hi); }
__device__ __forceinline__ float bflo(unsigned w) { return __uint_as_float(w << 16); }
__device__ __forceinline__ float bfhi(unsigned w) { return __uint_as_float(w & 0xffff0000u); }

#define XB_TMO      128
#define XB_XCNT(j)  (256  + 64 * (j))
#define XB_XSUB(j)  (1280 + 64 * (j))
#define XB_XGEN(j)  (2304 + 64 * (j))
#define XB_TOP      3328
#define XB_TOPGEN   3392
#define XCD_BAR_WORDS 3456
#define XB_SPIN_CAP (1u << 23)

__device__ __forceinline__ unsigned xb_ld(unsigned* p)              { return __hip_atomic_load(p, __ATOMIC_RELAXED, __HIP_MEMORY_SCOPE_AGENT); }
__device__ __forceinline__ unsigned xb_add(unsigned* p, unsigned v) { return __hip_atomic_fetch_add(p, v, __ATOMIC_RELAXED, __HIP_MEMORY_SCOPE_AGENT); }
__device__ __forceinline__ unsigned xb_xcc_id() { return (unsigned)__builtin_amdgcn_s_getreg((3 << 11) | 20) & 0xFu; }
#define XB_SPIN(cond, bar) do { unsigned _sp = 0; while (cond) { __builtin_amdgcn_s_sleep(1); \
    if ((++_sp & 255u) == 0u) { if (xb_ld(&(bar)[XB_TMO])) break; if (_sp > XB_SPIN_CAP) { atomicAdd(&(bar)[XB_TMO], 1u); break; } } } } while (0)

struct XcdBarrier {
    unsigned* bar; unsigned x;
    volatile LAS unsigned* st;
};

__device__ __forceinline__ XcdBarrier xcd_barrier_post(unsigned* bar, volatile LAS unsigned* st) {
    XcdBarrier b; b.bar = bar; b.x = xb_xcc_id(); b.st = st;
    if (threadIdx.x == 0) (void)xb_add(&bar[XB_XCNT(b.x)], 1u);
    return b;
}
__device__ __forceinline__ void xcd_barrier_complete(unsigned* bar, unsigned x, unsigned& nloc, unsigned& nx) {
    const unsigned G = gridDim.x * gridDim.y * gridDim.z;
    unsigned sum, cnt, mine, sp = 0u;
    for (;;) {
        sum = 0u; cnt = 0u; mine = 0u;
#pragma unroll
        for (unsigned j = 0; j < 16; ++j) { const unsigned c = xb_ld(&bar[XB_XCNT(j)]); sum += c; cnt += (c > 0u) ? 1u : 0u; mine = (j == x) ? c : mine; }
        if (sum == G) break;
        __builtin_amdgcn_s_sleep(1);
        if ((++sp & 255u) == 0u) { if (xb_ld(&bar[XB_TMO])) break; if (sp > XB_SPIN_CAP) { atomicAdd(&bar[XB_TMO], 1u); break; } }
    }
    nloc = mine > 0u ? mine : 1u; nx = cnt > 0u ? cnt : 1u;
}

__device__ __forceinline__ void xcd_barrier(const XcdBarrier& b) {
    asm volatile("s_waitcnt vmcnt(0)" ::: "memory");
    __syncthreads();
    if (threadIdx.x == 0) {
        unsigned* bar = b.bar;
        __builtin_amdgcn_s_waitcnt(0);
        unsigned nloc = b.st[0], nx = b.st[1];
        if (nloc == 0u) { xcd_barrier_complete(bar, b.x, nloc, nx); b.st[0] = nloc; b.st[1] = nx; }
        const unsigned old = xb_add(&bar[XB_XSUB(b.x)], 1u);
        const unsigned gen = old / nloc;
        if (old + 1u == (gen + 1u) * nloc) {
            __builtin_amdgcn_fence(__ATOMIC_RELEASE, "agent");
            asm volatile("s_waitcnt vmcnt(0)" ::: "memory");
            const unsigned og = xb_add(&bar[XB_TOP], 1u);
            const unsigned tg = og / nx;
            if (og + 1u == (tg + 1u) * nx) xb_add(&bar[XB_TOPGEN], 1u);
            else XB_SPIN(xb_ld(&bar[XB_TOPGEN]) == tg, bar);
            __builtin_amdgcn_fence(__ATOMIC_ACQUIRE, "agent");
            xb_add(&bar[XB_XGEN(b.x)], 1u);
            asm volatile("s_waitcnt vmcnt(0)" ::: "memory");
        } else {
            XB_SPIN(xb_ld(&bar[XB_XGEN(b.x)]) == gen, bar);
            __builtin_amdgcn_fence(__ATOMIC_ACQUIRE, "agent");
            asm volatile("s_waitcnt vmcnt(0)" ::: "memory");
        }
    }
    __syncthreads();
}

constexpr int PTR_OFF = LDSCTL_OFF + 1024;
constexpr int I_OUT = 29, I_WS = 30, N_PTRS = 31;
__device__ __forceinline__ unsigned long long tbl_u64(LAS unsigned char* lds, int i) {
    const unsigned long long v = ((volatile LAS unsigned long long*)(lds + PTR_OFF))[i];
    const unsigned lo = __builtin_amdgcn_readfirstlane((unsigned)v), hi = __builtin_amdgcn_readfirstlane((unsigned)(v >> 32));
    return ((unsigned long long)hi << 32) | lo;
}
__device__ __forceinline__ const float* tbl_in(LAS unsigned char* lds, int i) { return (const float*)(const GAS float*)tbl_u64(lds, i); }
__device__ __forceinline__ unsigned char* tbl_ws(LAS unsigned char* lds) { return (unsigned char*)(GAS unsigned char*)tbl_u64(lds, I_WS); }
struct Geo { int tid, lane, wave, vcu, G, gw, NGW; };
__device__ __forceinline__ Geo geo() { Geo g; g.tid = tid_fresh(); g.lane = g.tid & 63; g.wave = __builtin_amdgcn_readfirstlane(g.tid >> 6);
    g.G = gridDim.x; { const int bx = blockIdx.x; g.vcu = (g.G % 8 == 0) ? (bx % 8) * (g.G / 8) + bx / 8 : bx; } g.gw = g.vcu * NWAVES + g.wave; g.NGW = g.G * NWAVES; return g; }
__device__ __forceinline__ float wave_sum(float v) {
#pragma unroll
    for (int o = 1; o < 64; o <<= 1) v += __shfl_xor(v, o);
    return v;
}
__device__ __forceinline__ void p0_transpose_item(const float* W, const float* g, int K, int N, bf16* WT, int k0, int n0, int drow0, LAS float* scr, int lane) {
    const int ldw = K + 128;
    const int c = lane & 7;
    f32x4 ga = (f32x4){1.f, 1.f, 1.f, 1.f}, gb = ga;
    if (g) { ga = *(const GAS f32x4*)(g + k0 + 8 * c); gb = *(const GAS f32x4*)(g + k0 + 8 * c + 4); }
#pragma unroll 8
    for (int i = 0; i < 32; ++i) { const int kk = 2 * i + (lane >> 5); scr[kk * 33 + (lane & 31)] = __builtin_nontemporal_load(&W[(size_t)(k0 + kk) * N + n0 + (lane & 31)]); }
    LDS_WAIT(); asm volatile("" ::: "memory");
#pragma unroll
    for (int j = 0; j < 4; ++j) { const int n = (lane >> 3) + 8 * j; const LAS float* s = scr + (8 * c) * 33 + n;
        v4u o; o.x = pk2(s[0 * 33] * ga.x, s[1 * 33] * ga.y); o.y = pk2(s[2 * 33] * ga.z, s[3 * 33] * ga.w); o.z = pk2(s[4 * 33] * gb.x, s[5 * 33] * gb.y); o.w = pk2(s[6 * 33] * gb.z, s[7 * 33] * gb.w);
        *(GAS v4u*)(WT + (size_t)(drow0 + n) * ldw + k0 + 8 * c) = o; }
    LDS_WAIT(); asm volatile("" ::: "memory");
}
__device__ __forceinline__ void p0_plain(const float* W, const float* g, int K, int N, bf16* WT, int item, LAS float* scr, int lane) {
    const int nblk = N / 32, kb = item / nblk, nb = item % nblk;
    p0_transpose_item(W, g, K, N, WT, 64 * kb, 32 * nb, 32 * nb, scr, lane);
}
__device__ __forceinline__ void p0_gu(const float* W, const float* g, bf16* WT, int up, int item, LAS float* scr, int lane) {
    const int nblk = DFF / 32, kb = item / nblk, nb = item % nblk, n0 = 32 * nb;
    p0_transpose_item(W, g, DM, DFF, WT, 64 * kb, n0, (n0 >> 7) * 256 + up * 128 + (n0 & 127), scr, lane);
}

__device__ __forceinline__ void xcast_phase(const float* x, bf16* xb, float* rowss) {
    const Geo F = geo(); const int gw = F.gw, NGW = F.NGW;
    for (int m = gw; m < M; m += NGW) {
        const GAS f32x4* xr = (const GAS f32x4*)(x + (size_t)m * DM) + F.lane;
        f32x4 v[8]; float s = 0.f;
#pragma unroll
        for (int j = 0; j < 8; ++j) v[j] = xr[64 * j];
        GAS v2u* o8 = (GAS v2u*)(xb + (size_t)m * LD2) + F.lane;
#pragma unroll
        for (int j = 0; j < 8; ++j) { v2u w; w.x = pk2(v[j].x, v[j].y); w.y = pk2(v[j].z, v[j].w); o8[64 * j] = w;
            const float r0 = bflo(w.x), r1 = bfhi(w.x), r2 = bflo(w.y), r3 = bfhi(w.y); s += (r0 * r0 + r1 * r1) + (r2 * r2 + r3 * r3); }
        s = wave_sum(s);
        if (F.lane < 32) rowss[(size_t)m * 32 + F.lane] = F.lane == 0 ? s : 0.f;
    }
}
__device__ __forceinline__ void combineA_phase(const bf16* OC, bf16* O, float lam, float post, const float* sg) {
    const Geo F = geo(); const int gw = F.gw, NGW = F.NGW;
    const int half = F.lane >> 5, li = F.lane & 31;
    const f32x4 s0 = *((const GAS f32x4*)sg + 2 * li), s1 = *((const GAS f32x4*)sg + 2 * li + 1);
    for (int t = gw; t < M * 4; t += NGW) {
        const int task = t * 2 + half, row = task >> 3, h = task & 7;
        const v4u a = *(const GAS v4u*)(OC + (size_t)row * LDOC + (h * 2 + 0) * 256 + li * 8);
        const v4u b = *(const GAS v4u*)(OC + (size_t)row * LDOC + (h * 2 + 1) * 256 + li * 8);
        float d[8] = {bflo(a.x) - lam * bflo(b.x), bfhi(a.x) - lam * bfhi(b.x), bflo(a.y) - lam * bflo(b.y), bfhi(a.y) - lam * bfhi(b.y),
                      bflo(a.z) - lam * bflo(b.z), bfhi(a.z) - lam * bfhi(b.z), bflo(a.w) - lam * bflo(b.w), bfhi(a.w) - lam * bfhi(b.w)};
        float s = 0.f;
#pragma unroll
        for (int i = 0; i < 8; ++i) s += d[i] * d[i];
        s += __shfl_xor(s, 1); s += __shfl_xor(s, 2); s += __shfl_xor(s, 4); s += __shfl_xor(s, 8); s += __shfl_xor(s, 16);
        const float rs = post / sqrtf(s * (1.f / 256.f) + RMS_EPS);
        v4u o; o.x = pk2(d[0] * rs * s0.x, d[1] * rs * s0.y); o.y = pk2(d[2] * rs * s0.z, d[3] * rs * s0.w);
        o.z = pk2(d[4] * rs * s1.x, d[5] * rs * s1.y); o.w = pk2(d[6] * rs * s1.z, d[7] * rs * s1.w);
        *(GAS v4u*)(O + (size_t)row * LD2 + h * 256 + li * 8) = o;
    }
}

__device__ __forceinline__ int clampi(int v, int lo, int hi) { return v < lo ? lo : (v > hi ? hi : v); }
__device__ __forceinline__ void attnA_phase(const bf16* QKV, bf16* OC, const float* gq, const float* gk, unsigned* qctr, LAS unsigned char* ldsl) {
    const Geo F = geo();
    volatile LAS unsigned* slot = (volatile LAS unsigned*)(ldsl + MISC_OFF) + 16;
    float gmq = fmaxf(fabsf(gq[F.lane]), fabsf(gq[F.lane + 64])), gmk = fmaxf(fabsf(gk[F.lane]), fabsf(gk[F.lane + 64]));
#pragma unroll
    for (int o = 1; o < 64; o <<= 1) { gmq = fmaxf(gmq, __shfl_xor(gmq, o)); gmk = fmaxf(gmk, __shfl_xor(gmk, o)); }
    const float twoB = 2.f * gmq * gmk * att::ISCALE;
    const int qi = blockIdx.x & 7;
    unsigned* ctr = qctr + 64 * qi;
    for (;;) {
        if (F.tid == 0) {
            unsigned got = __hip_atomic_fetch_add(ctr, 1u, __ATOMIC_RELAXED, __HIP_MEMORY_SCOPE_AGENT), gq = (unsigned)qi;
            while (got >= 128u) {
                unsigned v[7];
#pragma unroll
                for (int k = 1; k < 8; ++k) v[k - 1] = xb_ld(qctr + 64 * ((qi + k) & 7));
                int pick = 0;
#pragma unroll
                for (int k = 7; k >= 1; --k) pick = v[k - 1] < 128u ? k : pick;
                if (pick == 0) break;
                gq = (unsigned)((qi + pick) & 7); got = __hip_atomic_fetch_add(qctr + 64 * gq, 1u, __ATOMIC_RELAXED, __HIP_MEMORY_SCOPE_AGENT);
            }
            slot[0] = got < 128u ? ((gq << 8) | got) : 0xffffffffu;
        }
        __syncthreads();
        const unsigned pa = (unsigned)__builtin_amdgcn_readfirstlane((int)slot[0]);
        __syncthreads();
        if (pa == 0xffffffffu) break;
        const int cq = (int)(pa >> 8); const unsigned p = pa & 255u;
        const int r = p >> 5, i = p & 31, qblk = (i & 1) ? 15 - (i >> 1) : 16 + (i >> 1);
        int h, bc;
        bc = cq >> 1;
        if ((cq & 1) == 0) h = r == 0 ? 7 : 5 - r; else h = r == 0 ? 6 : (r == 1 ? 5 : 3 - r);
        const int b = bc >> 1, c = bc & 1;
        const float slope = exp2f(-(float)(h + 1));
        const float needC = 0.5f * twoB + 30.f + logf(2.f / (expf(slope) - 1.f));
        const int q0 = qblk * 256;
        const size_t row0 = (size_t)b * SEQ;
        const bf16* Qb = QKV + (row0 + q0) * LDQA + (h * 2 + c) * 128;
        const bf16* Kh = QKV + row0 * LDQA + 2048 + (h * 2 + c) * 128;
        const bf16* Vh = QKV + row0 * LDQA + 4096 + h * 256;
        bf16* Ob = OC + (row0 + q0) * LDOC + (h * 2 + c) * 256;
        att::ModA2 mod; mod.slopeS = slope * att::ISCALE; mod.qk0 = q0 + (F.tid >> 6) * 32 + (F.lane & 31) - 4 * (F.lane >> 5);
        att::attn_unit_dma_A<LDQA, LDQA, LDOC, att::ModA2>((const att::bf16*)Qb, (const att::bf16*)Kh, (const att::bf16*)Vh, (att::bf16*)Ob, q0, SEQ / 64, slope, needC, mod, ldsl + RING_OFF,
                                                          (volatile LAS float*)(ldsl + MISC_OFF) + 24);
    }
}
__device__ __forceinline__ void attnB_phase(const bf16* QKV, bf16* O, const float* rel_bias, LAS unsigned char* ldsl) {
    const Geo F = geo(); const int wid = F.tid >> 6, r32 = F.lane & 31, hi = F.lane >> 5;
    float* tbl = (float*)((char*)(ldsl + RING_OFF) + att::TBL2_OFF);
    for (int uidx = F.vcu; uidx < 1024; uidx += F.G) {
        const int qblk = uidx & 31, combo = uidx >> 5, h = combo & 15, b = combo >> 4;
        const int r0 = qblk * 4, lo = clampi(r0 - 4, 0, 120), hi_ = clampi(r0 - 1, 0, 120) + 8; const int NT = hi_ - lo;
        const size_t row0 = (size_t)b * SEQ;
        const bf16* Qb = QKV + (row0 + qblk * 256) * LDQA + h * 128;
        const bf16* Kh = QKV + (row0 + lo * 64) * LDQA + 2048 + h * 128;
        const bf16* Vh = QKV + (row0 + lo * 64) * LDQA + 4096 + h * 128;
        bf16* Ob = O + (row0 + qblk * 256) * LD2 + h * 128;
        for (int i = F.tid; i < att::TBL_FLOATS; i += NWAVES * 64) { const int j = i - 64; tbl[i] = (j >= 0 && j < 465) ? rel_bias[h * 465 + j] * att::ISCALE : 0.f; }
        const int pos = qblk * 256 + wid * 32 + r32, r = pos >> 6, c = pos & 63;
        att::ModB2 mod; mod.tbl = tbl; mod.r = r; mod.r_start = clampi(r - 4, 0, 120); mod.kr0 = lo; mod.tb0 = 64 + 4 * hi - c + 15; mod.kc0 = 4 * hi - clampi(c - 8, 0, 48);
        { const int pw = qblk * 256 + wid * 32; mod.rs_u = __builtin_amdgcn_readfirstlane(clampi((pw >> 6) - 4, 0, 120)); mod.cw0 = __builtin_amdgcn_readfirstlane(pw & 63); }
        att::attn_unit_dma<4, LDQA, LDQA, LD2, att::ModB2>((const att::bf16*)Qb, (const att::bf16*)Kh, (const att::bf16*)Vh, (att::bf16*)Ob, NT, mod, ldsl + RING_OFF);
    }
}
__device__ __forceinline__ void attnC_phase(const bf16* QKV, bf16* O, const float* sink, LAS unsigned char* ldsl) {
    const Geo F = geo(); const int wid = F.tid >> 6, r32 = F.lane & 31, hi = F.lane >> 5;
    for (int uidx = F.vcu; uidx < 1024; uidx += F.G) {
        const int qblk = uidx & 31, combo = uidx >> 5, h = combo & 15, b = combo >> 4, kv = h >> 2;
        const int q0 = qblk * 256, klo = q0 - 128 < 0 ? 0 : q0 - 128, khi = q0 + 384 > SEQ ? SEQ : q0 + 384, NT = (khi - klo) / 64;
        const size_t row0 = (size_t)b * SEQ;
        const bf16* Qb = QKV + (row0 + q0) * LDQC + h * 128;
        const bf16* Kh = QKV + (row0 + klo) * LDQC + 2048 + kv * 128;
        const bf16* Vh = QKV + (row0 + klo) * LDQC + 2560 + kv * 128;
        bf16* Ob = O + (row0 + q0) * LD2 + h * 128;
        att::ModC2 mod; mod.slopeS = exp2f(-0.5f * (float)(h + 1)) * att::ISCALE; mod.sinkS = sink[h] * att::ISCALE; mod.qk0 = q0 + wid * 32 + r32 - klo - 4 * hi; mod.qw0 = __builtin_amdgcn_readfirstlane(q0 + wid * 32 - klo);
        att::attn_unit_dma<4, LDQC, LDQC, LD2, att::ModC2>((const att::bf16*)Qb, (const att::bf16*)Kh, (const att::bf16*)Vh, (att::bf16*)Ob, NT, mod, ldsl + RING_OFF);
    }
}

__device__ __forceinline__ void ph_prologue(LAS unsigned char* lds) {
    const Geo F = geo();
    unsigned char* ws = tbl_ws(lds);
    bf16* const WGU = (bf16*)(ws + WS_WGU); bf16* const WDN = (bf16*)(ws + WS_WDN); bf16* const WQKV = (bf16*)(ws + WS_WQKV); bf16* const WO = (bf16*)(ws + WS_WO);
    LAS float* scr = (LAS float*)(lds + RING_OFF + F.wave * 16384);
    constexpr int IF = (DM / 64) * (DFF / 32);
    static_assert(IF == (DFF / 64) * (DM / 32), "item counts");
    for (int Li = 0; Li < DEPTH; ++Li) {
        const int L = DEPTH - 1 - Li;
        const int kind = L % 3, j = L / 3, nq = kind == 2 ? 3072 : 6144;
        const float* wqkv = kind == 0 ? tbl_in(lds, 10) + (size_t)j * DM * 6144 : tbl_in(lds, kind == 1 ? 19 : 24);
        const float* wo = kind == 0 ? tbl_in(lds, 18) + (size_t)j * DM * DM : tbl_in(lds, kind == 1 ? 23 : 28);
        const int IQ = (DM / 64) * (nq / 32), IO = (DM / 64) * (DM / 32), NIT = 6 * IF + IQ + IO;
        const size_t offF = (size_t)L * DM * DFF;
        bf16* gu1 = WGU + (size_t)(2 * L) * NGU * LD2; bf16* gu2 = gu1 + (size_t)NGU * LD2;
        bf16* dn1 = WDN + (size_t)(2 * L) * DM * LDF; bf16* dn2 = dn1 + (size_t)DM * LDF;
        for (int it = F.gw; it < NIT; it += F.NGW) {
            int r = NIT - 1 - it;
            if (r < IF) { p0_gu(tbl_in(lds, 2) + offF, tbl_in(lds, 1) + L * DM, gu1, 0, r, scr, F.lane); continue; } r -= IF;
            if (r < IF) { p0_gu(tbl_in(lds, 3) + offF, tbl_in(lds, 1) + L * DM, gu1, 1, r, scr, F.lane); continue; } r -= IF;
            if (r < IF) { p0_plain(tbl_in(lds, 4) + offF, nullptr, DFF, DM, dn1, r, scr, F.lane); continue; } r -= IF;
            if (r < IF) { p0_gu(tbl_in(lds, 7) + offF, tbl_in(lds, 6) + L * DM, gu2, 0, r, scr, F.lane); continue; } r -= IF;
            if (r < IF) { p0_gu(tbl_in(lds, 8) + offF, tbl_in(lds, 6) + L * DM, gu2, 1, r, scr, F.lane); continue; } r -= IF;
            if (r < IF) { p0_plain(tbl_in(lds, 9) + offF, nullptr, DFF, DM, dn2, r, scr, F.lane); continue; } r -= IF;
            if (r < IQ) { p0_plain(wqkv, tbl_in(lds, 5) + L * DM, DM, nq, WQKV + (size_t)L * 6144 * LD2, r, scr, F.lane); continue; } r -= IQ;
            p0_plain(wo, nullptr, DM, DM, WO + (size_t)L * DM * LD2, r, scr, F.lane);
        }
    }
    xcast_phase(tbl_in(lds, 0), (bf16*)(ws + WS_H), (float*)(ws + WS_ROWSS));
}
__device__ __forceinline__ int ver_ffn(int s) { return s + ((s + 1) >> 1); }
__device__ __forceinline__ float* rowss_of(unsigned char* ws, int v) { return (float*)(ws + WS_ROWSS) + (size_t)v * M * 32; }
__device__ __forceinline__ void ph_gemm_gu(LAS unsigned char* lds, int s) {
    unsigned char* ws = tbl_ws(lds); const int G = gridDim.x;
    pg8::Gemm g{(const bf16*)(ws + WS_H), (const bf16*)(ws + WS_WGU) + (size_t)s * NGU * LD2, M, NGU, DM, LD2, LD2}; pg8::StaticOrder S; S.init(M, NGU, G, (int)blockIdx.x);
    volatile LAS int* tag = (volatile LAS int*)(lds + MISC_OFF) + 20; if (threadIdx.x == 0) *tag = -1;
    pg8::EpiSwiGLU E{(bf16*)(ws + WS_ACT), LDF, pg8::RstdPanel{rowss_of(ws, ver_ffn(s)), (LAS float*)(lds + RSTD_OFF), tag}};
    pg8::gemm_phase<pg8::EpiSwiGLU, pg8::StaticOrder, true, true>(lds + RING_OFF, g, S, E);
}
__device__ __forceinline__ void ph_gemm_down(LAS unsigned char* lds, int s) {
    unsigned char* ws = tbl_ws(lds); const int G = gridDim.x;
    pg8::Gemm g{(const bf16*)(ws + WS_ACT), (const bf16*)(ws + WS_WDN) + (size_t)s * DM * LDF, M, DM, DFF, LDF, LDF}; pg8::StaticOrder S; S.init(M, DM, G, (int)blockIdx.x);
    const bool last = s == 2 * DEPTH - 1;
    pg8::EpiResid E{s == 0 ? tbl_in(lds, 0) : nullptr, (const bf16*)(ws + WS_H), last ? nullptr : (bf16*)(ws + WS_H), last ? (float*)tbl_in(lds, I_OUT) : nullptr, last ? nullptr : rowss_of(ws, ver_ffn(s) + 1), LD2, DM, 0.5f};
    pg8::gemm_phase<pg8::EpiResid, pg8::StaticOrder, true, true>(lds + RING_OFF, g, S, E);
}
__device__ __forceinline__ void ph_gemm_qkv(LAS unsigned char* lds, int L) {
    unsigned char* ws = tbl_ws(lds); const int G = gridDim.x; const int nq = (L % 3) == 2 ? 3072 : 6144;
    pg8::Gemm g{(const bf16*)(ws + WS_H), (const bf16*)(ws + WS_WQKV) + (size_t)L * 6144 * LD2, M, nq, DM, LD2, LD2}; pg8::StaticOrder S; S.init(M, nq, G, (int)blockIdx.x);
    const int kind = L % 3, j = L / 3;
    const float* gq = tbl_in(lds, kind == 0 ? 11 : (kind == 1 ? 20 : 25)) + (kind == 0 ? j * HD : 0);
    const float* gk = tbl_in(lds, kind == 0 ? 12 : (kind == 1 ? 21 : 26)) + (kind == 0 ? j * HD : 0);
    volatile LAS int* tag = (volatile LAS int*)(lds + MISC_OFF) + 20; if (threadIdx.x == 0) *tag = -1;
    pg8::EpiQKV E{(bf16*)(ws + WS_QKV), nq + 128, pg8::RstdPanel{rowss_of(ws, 3 * L + 1), (LAS float*)(lds + RSTD_OFF), tag}, gq, gk, kind == 2 ? 4 : 16, (LAS float*)(lds + QKN_OFF)};
    pg8::gemm_phase<pg8::EpiQKV, pg8::StaticOrder, true, true>(lds + RING_OFF, g, S, E);
}
__device__ __forceinline__ void ph_gemm_wo(LAS unsigned char* lds, int L) {
    unsigned char* ws = tbl_ws(lds); const int G = gridDim.x;
    pg8::Gemm g{(const bf16*)(ws + WS_O), (const bf16*)(ws + WS_WO) + (size_t)L * DM * LD2, M, DM, DM, LD2, LD2}; pg8::StaticOrder S; S.init(M, DM, G, (int)blockIdx.x);
    pg8::EpiResid E{nullptr, (const bf16*)(ws + WS_H), (bf16*)(ws + WS_H), nullptr, rowss_of(ws, 3 * L + 2), LD2, DM, 1.0f};
    pg8::gemm_phase<pg8::EpiResid, pg8::StaticOrder, true, true>(lds + RING_OFF, g, S, E);
}
__device__ __forceinline__ void ph_combineA(LAS unsigned char* lds, int L) {
    unsigned char* ws = tbl_ws(lds); const int j = L / 3, lane = threadIdx.x & 63;
    const float lambda_init = 0.8f - 0.6f * expf(-0.3f * (float)L);
    const float* lq1 = tbl_in(lds, 13) + j * HD; const float* lk1 = tbl_in(lds, 14) + j * HD; const float* lq2 = tbl_in(lds, 15) + j * HD; const float* lk2 = tbl_in(lds, 16) + j * HD;
    const float s1 = wave_sum(lq1[lane] * lk1[lane] + lq1[lane + 64] * lk1[lane + 64]);
    const float s2 = wave_sum(lq2[lane] * lk2[lane] + lq2[lane + 64] * lk2[lane + 64]);
    const float lam = expf(s1) - expf(s2) + lambda_init;
    combineA_phase((const bf16*)(ws + WS_OC), (bf16*)(ws + WS_O), lam, 1.0f - lambda_init, tbl_in(lds, 17) + j * 256);
}

struct Args { const float* in[29]; float* out; unsigned char* ws; };
__global__ void __launch_bounds__(NWAVES * 64, 2) fwd(Args args) {
    extern __shared__ __attribute__((aligned(16))) unsigned char lds_raw[];
    LAS unsigned char* lds = (LAS unsigned char*)lds_raw;
    {   const int tid = threadIdx.x;
        for (int u = tid; u < (LDS_BYTES - LDSCTL_OFF) / 4; u += NWAVES * 64) ((LAS unsigned*)(lds + LDSCTL_OFF))[u] = 0u;
        __syncthreads();
        if (tid == 0) { LAS unsigned long long* t = (LAS unsigned long long*)(lds + PTR_OFF);
#pragma unroll
            for (int i = 0; i < 29; ++i) t[i] = (unsigned long long)args.in[i];
            t[I_OUT] = (unsigned long long)args.out; t[I_WS] = (unsigned long long)args.ws; }
        __syncthreads();
    }
    { volatile LAS unsigned* MISC = (volatile LAS unsigned*)(lds + MISC_OFF); (void)xcd_barrier_post((unsigned*)tbl_ws(lds) + CW_BAR, MISC + 8); }
#define GRID_BAR() do { XcdBarrier b_; b_.bar = (unsigned*)tbl_ws(lds) + CW_BAR; b_.x = xb_xcc_id(); b_.st = (volatile LAS unsigned*)(lds + MISC_OFF) + 8; xcd_barrier(b_); } while (0)

    ph_prologue(lds);
    GRID_BAR();
    for (int s = 0; s < 2 * DEPTH; ++s) {
        const int L = s >> 1;
        ph_gemm_gu(lds, s);
        GRID_BAR();
        ph_gemm_down(lds, s);
        if (s == 2 * DEPTH - 1) break;
        GRID_BAR();
        if ((s & 1) == 0) {
            const int kind = L % 3;
            ph_gemm_qkv(lds, L);
            GRID_BAR();
            if (kind == 0) {
#ifndef NO_A
                { unsigned char* ws = tbl_ws(lds); const int j_ = L / 3; attnA_phase((const bf16*)(ws + WS_QKV), (bf16*)(ws + WS_OC), tbl_in(lds, 11) + j_ * HD, tbl_in(lds, 12) + j_ * HD, (unsigned*)ws + CW_Q + j_ * 8 * 64, lds); }
#endif
                GRID_BAR();
                ph_combineA(lds, L);
            } else if (kind == 1) {
#ifndef NO_B
                { unsigned char* ws = tbl_ws(lds); attnB_phase((const bf16*)(ws + WS_QKV), (bf16*)(ws + WS_O), tbl_in(lds, 22), lds); }
#endif
            } else {
#ifndef NO_C
                { unsigned char* ws = tbl_ws(lds); attnC_phase((const bf16*)(ws + WS_QKV), (bf16*)(ws + WS_O), tbl_in(lds, 27), lds); }
#endif
            }
            GRID_BAR();
            ph_gemm_wo(lds, L);
            GRID_BAR();
        }
    }
}

extern "C" void kernel_launch(void* const* d_in, const int* in_sizes, int n_in, void* d_out, int out_size, void* d_ws, size_t ws_size, hipStream_t stream) {
    static int grid = 0;
    if (grid == 0) {
        if (n_in != 29 || in_sizes[0] != M * DM || out_size != M * DM || ws_size < WS_END) { fprintf(stderr, "kernel_launch: shape/workspace mismatch (n_in %d, ws %zu, need %zu); nothing launched\n", n_in, ws_size, (size_t)WS_END); grid = -1; return; }
        int dev = 0, cus = 0, per_cu = 0;
        if (hipGetDevice(&dev) != hipSuccess || hipDeviceGetAttribute(&cus, hipDeviceAttributeMultiprocessorCount, dev) != hipSuccess) { grid = -1; return; }
        if (hipFuncSetAttribute((const void*)fwd, hipFuncAttributeMaxDynamicSharedMemorySize, LDS_BYTES) != hipSuccess) { fprintf(stderr, "kernel_launch: hipFuncSetAttribute failed\n"); grid = -1; return; }
        if (hipOccupancyMaxActiveBlocksPerMultiprocessor(&per_cu, (const void*)fwd, NWAVES * 64, LDS_BYTES) != hipSuccess || per_cu < 1) fprintf(stderr, "kernel_launch: occupancy query reports %d\n", per_cu);
        (void)hipGetLastError();
        grid = cus;
    }
    if (grid < 0) return;
    if (hipMemsetAsync((char*)d_ws + WS_CTL, 0, CTL_ZERO_BYTES, stream) != hipSuccess) return;
    Args a{};
    for (int i = 0; i < 29; ++i) a.in[i] = (const float*)d_in[i];
    a.out = (float*)d_out; a.ws = (unsigned char*)d_ws;
    hipLaunchKernelGGL(fwd, dim3(grid), dim3(NWAVES * 64), LDS_BYTES, stream, a);
    const hipError_t le = hipPeekAtLastError();
    if (le != hipSuccess) fprintf(stderr, "kernel_launch: launch failed: %s\n", hipGetErrorName(le));
}
```

```cpp
#include <hip/hip_runtime.h>
#include <hip/hip_bf16.h>
#include <cstdio>
#include <cstdint>
#include <cmath>
__device__ __forceinline__ int tid_fresh() { int t = threadIdx.x; asm volatile("" : "+v"(t)); return t; }
namespace pg8 {
#define PG8_LAS __attribute__((address_space(3)))
typedef unsigned short bf16_t;
typedef short bf16x8 __attribute__((ext_vector_type(8)));
typedef float f32x4 __attribute__((ext_vector_type(4)));
typedef unsigned u32x4 __attribute__((ext_vector_type(4)));
constexpr int BM = 256, BK = 64, HALF = 128, HTB = HALF * BK * 2  , STAGE_BYTES = 8 * HTB, NXCD = 8, WGM = 8;

__host__ __device__ __forceinline__ int lds_byte(int r, int c) { const int st = (r >> 4) * 2 + (c >> 5), rr = r & 15, cc = c & 31, ob = rr * 64 + cc * 2; return st * 1024 + (ob ^ (((ob >> 9) & 1) << 5)); }
__host__ __device__ __forceinline__ void stage_rc(int b, int& R, int& C) { const int st = b / 1024, sb = b % 1024, swz = sb ^ (((sb >> 9) & 1) << 5); R = (st >> 1) * 16 + swz / 64; C = (st & 1) * 32 + (swz % 64) / 2; }
__host__ __device__ __forceinline__ int perm32(int rho) { const int n = rho >> 4, i = rho & 15; return 8 * (i >> 2) + 4 * n + (i & 3); }

struct Unit { int pm, pn; };
struct Gemm { const bf16_t* A; const bf16_t* Bt; int M, N, K, lda, ldb; };

struct StaticOrder {
    int nM, nN, nwg, G, c;
    __host__ __device__ void init(int M, int N, int G_, int c_) { nM = M / BM; nN = N / BM; nwg = nM * nN; G = G_; c = c_; }
    __host__ __device__ bool next(int i, Unit& u) const {
        const long L = (long)i * G + c; if (L >= nwg) return false;
        int wgid = (int)L; { const int q = nwg / NXCD, r = nwg % NXCD, xcd = wgid % NXCD, off = wgid / NXCD; wgid = (xcd < r ? xcd * (q + 1) : r * (q + 1) + (xcd - r) * q) + off; }
        const int nig = WGM * nN, gid = wgid / nig, fm = gid * WGM, gsz = (nM - fm) < WGM ? (nM - fm) : WGM;
        u.pm = fm + ((wgid % nig) % gsz); u.pn = (wgid % nig) / gsz; return true;
    }
    __device__ __forceinline__ void a_ready(const Unit&) const {}
    __device__ __forceinline__ void done(const Unit&) const {}
};


__device__ __forceinline__ unsigned cvt_pk_bf16(float lo, float hi) { unsigned r; asm volatile("v_cvt_pk_bf16_f32 %0, %1, %2" : "=v"(r) : "v"(lo), "v"(hi)); return r; }

constexpr float PG8_EPS = 1e-6f;
struct RstdPanel {
    const float* rowss; PG8_LAS float* tab; volatile PG8_LAS int* tag;
    __device__ __forceinline__ void ensure(int pm, int tid) const {
        const int have = __builtin_amdgcn_readfirstlane(*tag);
        if (have != pm) {
            asm volatile("s_waitcnt lgkmcnt(0)" ::: "memory"); __builtin_amdgcn_s_barrier(); asm volatile("" ::: "memory");
            if (tid < BM) { const f32x4* p = (const f32x4*)(rowss + (size_t)(pm * BM + tid) * 32); f32x4 v[8];
#pragma unroll
                for (int i = 0; i < 8; ++i) v[i] = p[i];
                float s = 0.f;
#pragma unroll
                for (int i = 0; i < 8; ++i) s += (v[i][0] + v[i][1]) + (v[i][2] + v[i][3]);
                tab[tid] = 1.0f / sqrtf(s * (1.0f / 2048.0f) + PG8_EPS); }
            if (tid == 0) *tag = pm;
            asm volatile("s_waitcnt lgkmcnt(0)" ::: "memory"); __builtin_amdgcn_s_barrier(); asm volatile("" ::: "memory");
        }
    }
    __device__ __forceinline__ void rows(int wr, int fr, float (&rs)[2][4]) const {
#pragma unroll
        for (int ai = 0; ai < 2; ++ai)
#pragma unroll
            for (int m = 0; m < 4; ++m) rs[ai][m] = tab[ai * HALF + wr * 64 + m * 16 + fr];
    }
};

struct EpiQKV {
    static constexpr bool PERM = true, AFTER_DRAIN = false;
    bf16_t* O; int ldc; RstdPanel rp; const float* gq; const float* gk; int nk; PG8_LAS float* P;
    __device__ __forceinline__ void operator()(const f32x4 (&acc)[2][2][4][2], const Unit& u, int wr, int wc, int fr, int fq) const {
        const int row0 = u.pm * BM + wr * 64 + fr, col0 = u.pn * BM + wc * 32 + 8 * fq;
        float rs[2][4]; rp.ensure(u.pm, (wr * 4 + wc) * 64 + fq * 16 + fr); rp.rows(wr, fr, rs);
        const int cls = u.pn < 8 ? 0 : (u.pn < 8 + (nk >> 1) ? 1 : 2);
        if (cls == 2) {
#pragma unroll
            for (int ai = 0; ai < 2; ++ai)
#pragma unroll
                for (int m = 0; m < 4; ++m) { bf16_t* rowp = O + (size_t)(row0 + ai * HALF + m * 16) * ldc + col0; const float r = rs[ai][m];
#pragma unroll
                    for (int bj = 0; bj < 2; ++bj) { const f32x4 v0 = acc[ai][bj][m][0] * r, v1 = acc[ai][bj][m][1] * r;
                        u32x4 w; w.x = cvt_pk_bf16(v0[0], v0[1]); w.y = cvt_pk_bf16(v0[2], v0[3]); w.z = cvt_pk_bf16(v1[0], v1[1]); w.w = cvt_pk_bf16(v1[2], v1[3]);
                        *(u32x4*)(rowp + bj * HALF) = w; } }
        } else {
            const float* g = cls == 0 ? gq : gk;
            const f32x4 g0 = *(const f32x4*)(g + wc * 32 + 8 * fq), g1 = *(const f32x4*)(g + wc * 32 + 8 * fq + 4);
#pragma unroll
            for (int ai = 0; ai < 2; ++ai)
#pragma unroll
                for (int m = 0; m < 4; ++m) { const float r = rs[ai][m];
#pragma unroll
                    for (int bj = 0; bj < 2; ++bj) { const f32x4 v0 = acc[ai][bj][m][0] * r, v1 = acc[ai][bj][m][1] * r;
                        float s = ((v0[0] * v0[0] + v0[1] * v0[1]) + (v0[2] * v0[2] + v0[3] * v0[3])) + ((v1[0] * v1[0] + v1[1] * v1[1]) + (v1[2] * v1[2] + v1[3] * v1[3]));
                        s += __shfl_xor(s, 16); s += __shfl_xor(s, 32);
                        if (fq == 0) P[((ai * HALF + wr * 64 + m * 16 + fr) * 2 + bj) * 4 + wc] = s; } }
            asm volatile("s_waitcnt lgkmcnt(0)" ::: "memory"); __builtin_amdgcn_s_barrier(); asm volatile("" ::: "memory");
#pragma unroll
            for (int ai = 0; ai < 2; ++ai)
#pragma unroll
                for (int m = 0; m < 4; ++m) { bf16_t* rowp = O + (size_t)(row0 + ai * HALF + m * 16) * ldc + col0; const float r = rs[ai][m];
#pragma unroll
                    for (int bj = 0; bj < 2; ++bj) { const f32x4 t = *(const PG8_LAS f32x4*)(P + ((ai * HALF + wr * 64 + m * 16 + fr) * 2 + bj) * 4);
                        const float rn = r / sqrtf(((t[0] + t[1]) + (t[2] + t[3])) * (1.0f / 128.0f) + PG8_EPS);
                        const f32x4 v0 = acc[ai][bj][m][0] * rn * g0, v1 = acc[ai][bj][m][1] * rn * g1;
                        u32x4 w; w.x = cvt_pk_bf16(v0[0], v0[1]); w.y = cvt_pk_bf16(v0[2], v0[3]); w.z = cvt_pk_bf16(v1[0], v1[1]); w.w = cvt_pk_bf16(v1[2], v1[3]);
                        *(u32x4*)(rowp + bj * HALF) = w; } }
        }
    }
};
__device__ __forceinline__ float silu_mul(float g, float u) { const float e = __builtin_amdgcn_exp2f(g * -1.4426950408889634f); return g * __builtin_amdgcn_rcpf(1.0f + e) * u; }
struct EpiSwiGLU {
    static constexpr bool PERM = true, AFTER_DRAIN = false;
    bf16_t* O; int ldc; RstdPanel rp;
    __device__ __forceinline__ void operator()(const f32x4 (&acc)[2][2][4][2], const Unit& u, int wr, int wc, int fr, int fq) const {
        const int row0 = u.pm * BM + wr * 64 + fr, col0 = u.pn * HALF + wc * 32 + 8 * fq;
        float rs[2][4]; rp.ensure(u.pm, (wr * 4 + wc) * 64 + fq * 16 + fr); rp.rows(wr, fr, rs);
#pragma unroll
        for (int ai = 0; ai < 2; ++ai)
#pragma unroll
            for (int m = 0; m < 4; ++m) { bf16_t* rowp = O + (size_t)(row0 + ai * HALF + m * 16) * ldc + col0; const float r = rs[ai][m];
                const f32x4 g0 = acc[ai][0][m][0] * r, g1 = acc[ai][0][m][1] * r, u0 = acc[ai][1][m][0] * r, u1 = acc[ai][1][m][1] * r;
                u32x4 w; w.x = cvt_pk_bf16(silu_mul(g0[0], u0[0]), silu_mul(g0[1], u0[1])); w.y = cvt_pk_bf16(silu_mul(g0[2], u0[2]), silu_mul(g0[3], u0[3]));
                w.z = cvt_pk_bf16(silu_mul(g1[0], u1[0]), silu_mul(g1[1], u1[1])); w.w = cvt_pk_bf16(silu_mul(g1[2], u1[2]), silu_mul(g1[3], u1[3]));
                *(u32x4*)rowp = w; }
    }
};
struct EpiResid {
    static constexpr bool PERM = true, AFTER_DRAIN = false;
    const float* base32; const bf16_t* xin; bf16_t* xb; float* out32; float* rowss; int ldc, ld32; float alpha;
    __device__ __forceinline__ void operator()(const f32x4 (&acc)[2][2][4][2], const Unit& u, int wr, int wc, int fr, int fq) const {
        const int row0 = u.pm * BM + wr * 64 + fr, col0 = u.pn * BM + wc * 32 + 8 * fq;
#pragma unroll
        for (int ai = 0; ai < 2; ++ai)
#pragma unroll
            for (int m = 0; m < 4; ++m) { const int row = row0 + ai * HALF + m * 16; const size_t off = (size_t)row * ldc + col0, off32 = (size_t)row * ld32 + col0; float ss = 0.f;
#pragma unroll
                for (int bj = 0; bj < 2; ++bj) { f32x4 b0, b1;
                    if (base32) { b0 = *(const f32x4*)(base32 + off32 + bj * HALF); b1 = *(const f32x4*)(base32 + off32 + bj * HALF + 4); }
                    else { const u32x4 w = *(const u32x4*)(xin + off + bj * HALF);
                        b0 = (f32x4){__uint_as_float(w.x << 16), __uint_as_float(w.x & 0xffff0000u), __uint_as_float(w.y << 16), __uint_as_float(w.y & 0xffff0000u)};
                        b1 = (f32x4){__uint_as_float(w.z << 16), __uint_as_float(w.z & 0xffff0000u), __uint_as_float(w.w << 16), __uint_as_float(w.w & 0xffff0000u)}; }
                    const f32x4 o0 = b0 + acc[ai][bj][m][0] * alpha, o1 = b1 + acc[ai][bj][m][1] * alpha;
                    u32x4 w; w.x = cvt_pk_bf16(o0[0], o0[1]); w.y = cvt_pk_bf16(o0[2], o0[3]); w.z = cvt_pk_bf16(o1[0], o1[1]); w.w = cvt_pk_bf16(o1[2], o1[3]);
                    if (xb) *(u32x4*)(xb + off + bj * HALF) = w;
                    if (out32) { *(f32x4*)(out32 + off32 + bj * HALF) = o0; *(f32x4*)(out32 + off32 + bj * HALF + 4) = o1; }
                    const float r0 = __uint_as_float(w.x << 16), r1 = __uint_as_float(w.x & 0xffff0000u), r2 = __uint_as_float(w.y << 16), r3 = __uint_as_float(w.y & 0xffff0000u);
                    const float r4 = __uint_as_float(w.z << 16), r5 = __uint_as_float(w.z & 0xffff0000u), r6 = __uint_as_float(w.w << 16), r7 = __uint_as_float(w.w & 0xffff0000u);
                    ss += ((r0 * r0 + r1 * r1) + (r2 * r2 + r3 * r3)) + ((r4 * r4 + r5 * r5) + (r6 * r6 + r7 * r7)); }
                if (rowss) { ss += __shfl_xor(ss, 16); ss += __shfl_xor(ss, 32); if (fq == 0) rowss[(size_t)row * 32 + u.pn * 4 + wc] = ss; }
                if (m & 1) asm volatile("" ::: "memory"); }
    }
};

template <class Epi, class Sched, bool ALIGN_EPI = false, bool SP2 = false>
__device__ __forceinline__ void gemm_phase(PG8_LAS unsigned char* lds, const Gemm g, const Sched& S, const Epi& E) {
    const int tid = tid_fresh(), wid = __builtin_amdgcn_readfirstlane(tid >> 6), lane = tid & 63, wr = wid >> 2, wc = wid & 3, fr = lane & 15, fq = lane >> 4;
    const int K = g.K, nt = K / BK;
    unsigned voffA[2], voffB[2];
#pragma unroll
    for (int i = 0; i < 2; ++i) { int R, C; stage_rc(tid * 16 + i * 8192, R, C); const int Rb = Epi::PERM ? ((R & ~31) + perm32(R & 31)) : R;
        voffA[i] = (unsigned)(R * g.lda + C) * 2u; voffB[i] = (unsigned)(Rb * g.ldb + C) * 2u; }
    const size_t kstep = (size_t)(BK * 2);
    const size_t hstepA = (size_t)HALF * g.lda * 2, hstepB = (size_t)HALF * g.ldb * 2;
    const size_t tstepA = 2 * hstepA, tstepB = 2 * hstepB;
    const unsigned ldsw = (unsigned)wid * 1024u;
    const int aoff = lds_byte(wr * 64 + fr, fq * 8), boff = lds_byte(wc * 32 + fr, fq * 8);
#define PG8_SA(b, h) (((b) * 2 + (h)) * HTB)
#define PG8_SB(b, h) ((4 + (b) * 2 + (h)) * HTB)
#define PG8_STAGE(bufoff, gbase, voff) do { _Pragma("unroll") for (int _i = 0; _i < 2; ++_i) \
        __builtin_amdgcn_global_load_lds((const unsigned*)((const char*)(gbase) + (voff)[_i]), (PG8_LAS unsigned*)(lds + (bufoff) + ldsw + _i * 8192), 16, 0, 0); } while (0)
#define PG8_LDA(dst, b, h) do { _Pragma("unroll") for (int m = 0; m < 4; ++m) _Pragma("unroll") for (int k = 0; k < 2; ++k) dst[m][k] = *(const PG8_LAS bf16x8*)(lds + PG8_SA(b, h) + aoff + m * 2048 + k * 1024); } while (0)
#define PG8_LDB(dst, b, h) do { _Pragma("unroll") for (int n = 0; n < 2; ++n) _Pragma("unroll") for (int k = 0; k < 2; ++k) dst[n][k] = *(const PG8_LAS bf16x8*)(lds + PG8_SB(b, h) + boff + n * 2048 + k * 1024); } while (0)
#define PG8_MMA(ai, bj, At, Bt) do { __builtin_amdgcn_s_setprio(1); _Pragma("unroll") for (int m = 0; m < 4; ++m) _Pragma("unroll") for (int n = 0; n < 2; ++n) _Pragma("unroll") for (int k = 0; k < 2; ++k) \
        acc[ai][bj][m][n] = __builtin_amdgcn_mfma_f32_16x16x32_bf16(Bt[n][k], At[m][k], acc[ai][bj][m][n], 0, 0, 0); __builtin_amdgcn_s_setprio(0); } while (0)
#define PG8_WAIT_V(n) asm volatile("s_waitcnt vmcnt(" #n ")" ::: "memory")
#define PG8_WAIT_L(n) asm volatile("s_waitcnt lgkmcnt(" #n ")" ::: "memory")
#define PG8_BAR __builtin_amdgcn_s_barrier()
#define PG8_SCHED __builtin_amdgcn_sched_barrier(0)
    Unit cur, nxt; int ui = 0;
    if (!S.next(0, cur)) return;
    f32x4 acc[2][2][4][2];
#pragma unroll
    for (int a = 0; a < 2; ++a)
#pragma unroll
        for (int b = 0; b < 2; ++b)
#pragma unroll
            for (int m = 0; m < 4; ++m)
#pragma unroll
                for (int n = 0; n < 2; ++n) acc[a][b][m][n] = (f32x4){0.f, 0.f, 0.f, 0.f};
    bf16x8 At[4][2], B0[2][2], B1[2][2];
    const char* cA = (const char*)g.A + (size_t)cur.pm * tstepA; const char* cB = (const char*)g.Bt + (size_t)cur.pn * tstepB;
    S.a_ready(cur);
    if constexpr (SP2) {
        PG8_STAGE(PG8_SB(0, 0), cB, voffB); PG8_STAGE(PG8_SB(0, 1), cB + hstepB, voffB); PG8_STAGE(PG8_SA(0, 0), cA, voffA); PG8_STAGE(PG8_SA(0, 1), cA + hstepA, voffA);
        if (wr == 1) PG8_BAR;
        PG8_WAIT_V(2); PG8_BAR;
        PG8_STAGE(PG8_SB(1, 0), cB + kstep, voffB); PG8_STAGE(PG8_SA(1, 0), cA + kstep, voffA); PG8_STAGE(PG8_SB(1, 1), cB + hstepB + kstep, voffB);
        PG8_WAIT_V(6); PG8_BAR;
    } else {
        PG8_STAGE(PG8_SB(0, 0), cB, voffB); PG8_STAGE(PG8_SA(0, 0), cA, voffA); PG8_STAGE(PG8_SB(0, 1), cB + hstepB, voffB); PG8_STAGE(PG8_SA(0, 1), cA + hstepA, voffA);
        if (wr == 1) PG8_BAR;
        PG8_WAIT_V(4); PG8_BAR;
        PG8_STAGE(PG8_SB(1, 0), cB + kstep, voffB); PG8_STAGE(PG8_SA(1, 0), cA + kstep, voffA); PG8_STAGE(PG8_SB(1, 1), cB + hstepB + kstep, voffB);
        PG8_WAIT_V(6); PG8_BAR;
    }
    for (;;) {
        const bool has_next = S.next(ui + 1, nxt);
        const char* nA = has_next ? (const char*)g.A + (size_t)nxt.pm * tstepA : cA; const char* nB = has_next ? (const char*)g.Bt + (size_t)nxt.pn * tstepB : cB;
        for (int t = 0; t < nt; t += 2) {
            const bool last = (t == nt - 2);
            const char* a1 = cA + (size_t)(t + 1) * kstep;
            const char* a2 = last ? nA : cA + (size_t)(t + 2) * kstep; const char* b2 = last ? nB : cB + (size_t)(t + 2) * kstep;
            const char* a3 = a2 + kstep; const char* b3 = b2 + kstep;
            if (last && has_next) S.a_ready(nxt);
            if constexpr (SP2) {
            PG8_LDB(B0, 0, 0); PG8_LDB(B1, 0, 1); PG8_SCHED; PG8_LDA(At, 0, 0); PG8_STAGE(PG8_SA(1, 1), a1 + hstepA, voffA);
            PG8_WAIT_V(8); PG8_WAIT_L(0); PG8_BAR; PG8_MMA(0, 0, At, B0); PG8_MMA(0, 1, At, B1); PG8_BAR; PG8_SCHED;
            PG8_LDA(At, 0, 1); PG8_STAGE(PG8_SB(0, 0), b2, voffB); PG8_STAGE(PG8_SB(0, 1), b2 + hstepB, voffB); PG8_STAGE(PG8_SA(0, 0), a2, voffA);
            PG8_WAIT_V(8); PG8_WAIT_L(0); PG8_BAR; PG8_MMA(1, 0, At, B0); PG8_MMA(1, 1, At, B1); PG8_BAR; PG8_SCHED;
            PG8_LDB(B0, 1, 0); PG8_LDB(B1, 1, 1); PG8_SCHED; PG8_LDA(At, 1, 0); PG8_STAGE(PG8_SA(0, 1), a2 + hstepA, voffA);
            PG8_WAIT_V(8); PG8_WAIT_L(0); PG8_BAR; PG8_MMA(0, 0, At, B0); PG8_MMA(0, 1, At, B1); PG8_BAR; PG8_SCHED;
            PG8_LDA(At, 1, 1); PG8_STAGE(PG8_SB(1, 0), b3, voffB); PG8_STAGE(PG8_SB(1, 1), b3 + hstepB, voffB); PG8_STAGE(PG8_SA(1, 0), a3, voffA);
            PG8_WAIT_V(8); PG8_WAIT_L(0); PG8_BAR; PG8_MMA(1, 0, At, B0); PG8_MMA(1, 1, At, B1); PG8_BAR; PG8_SCHED;
            } else {
            PG8_LDB(B0, 0, 0); PG8_SCHED; PG8_LDA(At, 0, 0); PG8_STAGE(PG8_SA(1, 1), a1 + hstepA, voffA);
            PG8_WAIT_L(8); PG8_BAR; PG8_WAIT_L(0); PG8_MMA(0, 0, At, B0); PG8_BAR; PG8_SCHED;
            PG8_LDB(B1, 0, 1); PG8_STAGE(PG8_SB(0, 0), b2, voffB);
            PG8_BAR; PG8_WAIT_L(0); PG8_MMA(0, 1, At, B1); PG8_BAR;
            PG8_LDA(At, 0, 1); PG8_STAGE(PG8_SA(0, 0), a2, voffA);
            PG8_BAR; PG8_WAIT_L(0); PG8_MMA(1, 0, At, B0); PG8_BAR; PG8_SCHED;
            PG8_STAGE(PG8_SB(0, 1), b2 + hstepB, voffB);
            PG8_WAIT_V(6); PG8_BAR; PG8_MMA(1, 1, At, B1); PG8_BAR;
            PG8_LDB(B0, 1, 0); PG8_SCHED; PG8_LDA(At, 1, 0); PG8_STAGE(PG8_SA(0, 1), a2 + hstepA, voffA);
            PG8_WAIT_L(8); PG8_BAR; PG8_WAIT_L(0); PG8_MMA(0, 0, At, B0); PG8_BAR; PG8_SCHED;
            PG8_LDB(B1, 1, 1); PG8_STAGE(PG8_SB(1, 0), b3, voffB);
            PG8_BAR; PG8_WAIT_L(0); PG8_MMA(0, 1, At, B1); PG8_BAR;
            PG8_LDA(At, 1, 1); PG8_STAGE(PG8_SA(1, 0), a3, voffA);
            PG8_BAR; PG8_WAIT_L(0); PG8_MMA(1, 0, At, B0); PG8_BAR; PG8_SCHED;
            PG8_STAGE(PG8_SB(1, 1), b3 + hstepB, voffB);
            PG8_WAIT_V(6); PG8_BAR; PG8_MMA(1, 1, At, B1); PG8_BAR;
            }
        }
        if constexpr (ALIGN_EPI) { if (wr == 0) PG8_BAR; }
        if constexpr (!Epi::AFTER_DRAIN) { E(acc, cur, wr, wc, fr, fq); S.done(cur); }
        if (!has_next) break;
#pragma unroll
        for (int a = 0; a < 2; ++a)
#pragma unroll
            for (int b = 0; b < 2; ++b)
#pragma unroll
                for (int m = 0; m < 4; ++m)
#pragma unroll
                    for (int n = 0; n < 2; ++n) acc[a][b][m][n] = (f32x4){0.f, 0.f, 0.f, 0.f};
        cur = nxt; cA = nA; cB = nB; ++ui;
        if constexpr (ALIGN_EPI) { if (wr == 1) PG8_BAR; }
    }
    PG8_WAIT_V(0);
    if constexpr (!ALIGN_EPI) { if (wr == 0) PG8_BAR; }
    PG8_BAR;
    if constexpr (Epi::AFTER_DRAIN) { E.fused(acc, cur, wr, wc, fr, fq, lds, wid, lane); S.done(cur); }
#undef PG8_SA
#undef PG8_SB
#undef PG8_STAGE
#undef PG8_LDA
#undef PG8_LDB
#undef PG8_MMA
#undef PG8_WAIT_V
#undef PG8_WAIT_L
#undef PG8_BAR
#undef PG8_SCHED
}
}
namespace att {
using bf16 = __hip_bfloat16;
using bf16x8 = __attribute__((ext_vector_type(8))) short;
using s16x4  = __attribute__((ext_vector_type(4))) short;
using f32x16 = __attribute__((ext_vector_type(16))) float;
using u32x4  = __attribute__((ext_vector_type(4))) unsigned;
constexpr int   D = 128, NW = 8, QBLK = 32, KVBLK = 64;
constexpr float SCALE = 0.088388347648318440f;
constexpr float ISCALE = 11.313708498984761f;
constexpr float THR = 8.f;
constexpr float NEG = -1e30f;
constexpr int TBL_FLOATS = 640;
#define KSWZ(row, colB) ((row) * 256 + ((colB) ^ (((row) & 7) << 4)))
#define SBAR() __builtin_amdgcn_sched_barrier(0)
__device__ __forceinline__ int crow(int r, int hi) { return (r & 3) + 8 * (r >> 2) + 4 * hi; }
__device__ __forceinline__ unsigned cvtpk(float lo, float hi) { unsigned r; asm volatile("v_cvt_pk_bf16_f32 %0, %1, %2" : "=v"(r) : "v"(lo), "v"(hi)); return r; }

__device__ __forceinline__ int v_rd_base(int lane) { return ((lane & 3) << 3) | (((lane >> 2) & 3) << 6) | (((lane >> 4) & 1) << 5) | (((lane >> 5) & 1) << 8); }
template <int OFF> __device__ __forceinline__ s16x4 tr_read(int vb) {
  s16x4 r; asm volatile("ds_read_b64_tr_b16 %0, %1 offset:%2" : "=&v"(r) : "v"(vb), "i"(OFF) : "memory"); return r;
}
constexpr int v_rd_off2(int ncb, int d0, int ks, int half) { return d0 * 512 + ks * (ncb * 1024) + half * (ncb * 512); }
template <int NCB> struct DmaGeo { static constexpr int KB = 16384, VB = 64 * NCB * 64, BUF = KB + VB, SCR = 2 * BUF, LDS_BYTES = SCR + NW * 256; };
constexpr int A_LDS_BYTES = DmaGeo<8>::LDS_BYTES, TBL2_OFF = DmaGeo<4>::LDS_BYTES;
template <int H> __device__ __forceinline__ void qk_half(f32x16& p, const char* Ks, const bf16x8* qr, int r32, int hi) {
  p = f32x16{};
#pragma unroll
  for (int d0 = 0; d0 < 8; ++d0) { const int cb = (d0 * 16 + hi * 8) * 2;
    const bf16x8 b = *reinterpret_cast<const bf16x8*>(Ks + KSWZ(32 * H + r32, cb));
    p = __builtin_amdgcn_mfma_f32_32x32x16_bf16(b, qr[d0], p, 0, 0, 0); }
}
__device__ __forceinline__ void sm_half(f32x16& p, float& m_reg, float& l_reg, float& alpha, bf16x8& paA, bf16x8& paB) {
  constexpr float C = SCALE * 1.4426950408889634f;
  float pmax = p[0];
#pragma unroll
  for (int r = 1; r < 16; ++r) pmax = fmaxf(pmax, p[r]);
  { auto rr = __builtin_amdgcn_permlane32_swap(__float_as_uint(pmax), __float_as_uint(pmax), false, false);
    pmax = fmaxf(__uint_as_float(rr[0]), __uint_as_float(rr[1])); }
  float mn;
  if (__builtin_expect(__all(pmax - m_reg <= THR / SCALE), 1)) { mn = m_reg; alpha = 1.f; }
  else { mn = fmaxf(m_reg, pmax); alpha = __builtin_amdgcn_exp2f((m_reg - mn) * C); m_reg = mn; }
  const float mnC = -mn * C;
#pragma unroll
  for (int r = 0; r < 16; ++r) p[r] = __builtin_amdgcn_exp2f(fmaf(p[r], C, mnC));
  float ps = 0;
#pragma unroll
  for (int r = 0; r < 16; ++r) ps += p[r];
  { auto rr = __builtin_amdgcn_permlane32_swap(__float_as_uint(ps), __float_as_uint(ps), false, false);
    ps = __uint_as_float(rr[0]) + __uint_as_float(rr[1]); }
  l_reg = l_reg * alpha + ps;
#define PK4(P, BASE, OUT) do { unsigned a0 = cvtpk(P[BASE + 0], P[BASE + 1]), a1 = cvtpk(P[BASE + 2], P[BASE + 3]);   \
    unsigned b0 = cvtpk(P[BASE + 4], P[BASE + 5]), b1 = cvtpk(P[BASE + 6], P[BASE + 7]);                              \
    auto r0 = __builtin_amdgcn_permlane32_swap(a0, b0, false, false); auto r1 = __builtin_amdgcn_permlane32_swap(a1, b1, false, false); \
    u32x4 w = {r0[0], r1[0], r0[1], r1[1]}; OUT = *reinterpret_cast<bf16x8*>(&w); } while (0)
  PK4(p, 0, paA); PK4(p, 8, paB);
#undef PK4
}
template <int NCB, int D0, int KS0> __device__ __forceinline__ void pv_pair(f32x16& oa, f32x16& ob, int vb, bf16x8 paA, bf16x8 paB) {
  const s16x4 al0 = tr_read<v_rd_off2(NCB, D0, KS0, 0)>(vb), ah0 = tr_read<v_rd_off2(NCB, D0, KS0, 1)>(vb), al1 = tr_read<v_rd_off2(NCB, D0, KS0 + 1, 0)>(vb), ah1 = tr_read<v_rd_off2(NCB, D0, KS0 + 1, 1)>(vb);
  const s16x4 bl0 = tr_read<v_rd_off2(NCB, D0 + 1, KS0, 0)>(vb), bh0 = tr_read<v_rd_off2(NCB, D0 + 1, KS0, 1)>(vb), bl1 = tr_read<v_rd_off2(NCB, D0 + 1, KS0 + 1, 0)>(vb), bh1 = tr_read<v_rd_off2(NCB, D0 + 1, KS0 + 1, 1)>(vb);
  asm volatile("s_waitcnt lgkmcnt(0)" ::: "memory"); SBAR();
#define PK(L, H) (bf16x8){L[0], L[1], L[2], L[3], H[0], H[1], H[2], H[3]}
  oa = __builtin_amdgcn_mfma_f32_32x32x16_bf16(PK(al0, ah0), paA, oa, 0, 0, 0);
  ob = __builtin_amdgcn_mfma_f32_32x32x16_bf16(PK(bl0, bh0), paA, ob, 0, 0, 0);
  oa = __builtin_amdgcn_mfma_f32_32x32x16_bf16(PK(al1, ah1), paB, oa, 0, 0, 0);
  ob = __builtin_amdgcn_mfma_f32_32x32x16_bf16(PK(bl1, bh1), paB, ob, 0, 0, 0);
#undef PK
}
template <int NCB, int KS0> __device__ __forceinline__ void pv_half(f32x16* o, int vb, bf16x8 paA, bf16x8 paB) {
  pv_pair<NCB, 0, KS0>(o[0], o[1], vb, paA, paB); pv_pair<NCB, 2, KS0>(o[2], o[3], vb, paA, paB);
  if constexpr (NCB == 8) { pv_pair<NCB, 4, KS0>(o[4], o[5], vb, paA, paB); pv_pair<NCB, 6, KS0>(o[6], o[7], vb, paA, paB); }
}
struct ModA2 {
  float slopeS; int qk0;
  template <int H> __device__ __forceinline__ bool skip(int) const { return false; }
  __device__ __forceinline__ float m_init() const { return -1e30f; }
  __device__ __forceinline__ float l_init() const { return 0.f; }
  template <int H> __device__ __forceinline__ void apply(f32x16& p, int jt) const {
    const float d0 = (float)(qk0 - jt * KVBLK - 32 * H), ns = -slopeS;
#pragma unroll
    for (int r = 0; r < 16; ++r) { const float c = (float)((r & 3) + 8 * (r >> 2)); p[r] = fmaf(ns, fabsf(d0 - c), p[r]); }
  }
};
struct ModC2 {
  float slopeS, sinkS; int qk0; int qw0;
  template <int H> __device__ __forceinline__ bool skip(int jt) const { const int d = qw0 - jt * KVBLK - 32 * H; return d > 128 + 31 || d < -(128 + 31); }
  __device__ __forceinline__ float m_init() const { return sinkS; }
  __device__ __forceinline__ float l_init() const { return 1.f; }
  template <int H> __device__ __forceinline__ void apply(f32x16& p, int jt) const {
    const float d0 = (float)(qk0 - jt * KVBLK - 32 * H), ns = -slopeS;
#pragma unroll
    for (int r = 0; r < 16; ++r) { const float c = (float)((r & 3) + 8 * (r >> 2)); const float e = fabsf(d0 - c); p[r] = e <= 128.f ? fmaf(ns, e, p[r]) : NEG; }
  }
};
struct ModB2 {
  const float* tbl;
  int r, r_start, kr0, tb0, kc0;
  int rs_u, cw0;
  template <int H> __device__ __forceinline__ bool skip(int jt) const { const int kr = kr0 + jt; if ((unsigned)(kr - rs_u) >= 8u) return true;
    const int lo = cw0 - 8 < 0 ? 0 : cw0 - 8, hi_ = (cw0 + 23 > 48 ? 48 : cw0 + 23) + 15; return 32 * H > hi_ || 32 * H + 31 < lo; }
  __device__ __forceinline__ float m_init() const { return -1e5f; }
  __device__ __forceinline__ float l_init() const { return 0.f; }
  template <int H> __device__ __forceinline__ void apply(f32x16& p, int jt) const {
    const int kr = kr0 + jt; const bool rowok = (unsigned)(kr - r_start) < 8u;
    int drow = kr - r + 7; drow = drow < 0 ? 0 : (drow > 14 ? 14 : drow);
    const float* tb = tbl + (tb0 + drow * 31 + 32 * H);
#pragma unroll
    for (int rr = 0; rr < 16; ++rr) { const int c = (rr & 3) + 8 * (rr >> 2);
      const bool ok = rowok && (unsigned)(c + 32 * H + kc0) < 16u; const float b = tb[c];
      p[rr] = ok ? p[rr] + b : NEG; }
  }
};
template <int NCB, int LDQ, int LDK, int LDO, class Mod>
__device__ __forceinline__ void attn_unit_dma(const bf16* __restrict__ Qb, const bf16* __restrict__ Kh, const bf16* __restrict__ Vh, bf16* __restrict__ Ob, int NT, const Mod& mod,
                                              __attribute__((address_space(3))) unsigned char* ldsl) {
  typedef __attribute__((address_space(3))) unsigned LU; typedef DmaGeo<NCB> G;
  const int tid = tid_fresh(), wid = __builtin_amdgcn_readfirstlane(tid >> 6), lane = tid & 63, r32 = lane & 31, hi = lane >> 5;
  char* lds = (char*)ldsl;
  float m_reg = mod.m_init(), l_reg = mod.l_init(); f32x16 o[NCB] = {}; bf16x8 qr[8];
  const bf16* Qw = Qb + (long)(wid * QBLK + r32) * LDQ + hi * 8;
#pragma unroll
  for (int d0 = 0; d0 < 8; ++d0) qr[d0] = *reinterpret_cast<const bf16x8*>(Qw + d0 * 16);
  const int krow = 4 * wid + (lane >> 4);
  const unsigned koff = (unsigned)(krow * LDK + (((lane & 15) ^ (krow & 7)) * 8)) * 2u;
  constexpr int PPK = NCB / 2, KSTEP = 64 / PPK;
  const int kk0 = (wid / PPK) * 8 + ((lane & 31) >> 2), vk0 = (kk0 & ~0xC) | ((kk0 & 4) << 1) | ((kk0 & 8) >> 1);
  const unsigned voff = (unsigned)(vk0 * LDK + ((2 * (wid % PPK) + (lane >> 5)) * 32 + (lane & 3) * 8)) * 2u;
  constexpr size_t TILE_B = (size_t)KVBLK * LDK * 2;
#define DMA_TILE(b, jt) do { const char* kg_ = (const char*)Kh + (size_t)(jt) * TILE_B; const char* vg_ = (const char*)Vh + (size_t)(jt) * TILE_B;                              \
    __builtin_amdgcn_global_load_lds((const unsigned*)(kg_ + koff), (LU*)(ldsl + (b) * G::BUF + wid * 1024), 16, 0, 0);                                                       \
    __builtin_amdgcn_global_load_lds((const unsigned*)(kg_ + koff + 32 * LDK * 2), (LU*)(ldsl + (b) * G::BUF + (wid + 8) * 1024), 16, 0, 0);                                  \
    _Pragma("unroll") for (int i_ = 0; i_ < PPK; ++i_)                                                                                                                        \
      __builtin_amdgcn_global_load_lds((const unsigned*)(vg_ + voff + i_ * KSTEP * LDK * 2), (LU*)(ldsl + (b) * G::BUF + G::KB + (wid + 8 * i_) * 1024), 16, 0, 0); } while (0)
#define TILE_SYNC() do { asm volatile("s_waitcnt vmcnt(0)" ::: "memory"); __syncthreads(); } while (0)
#define RESC(a) do { if (__any((a) < 1.f)) { asm volatile("; rescale (rare): keep this a real branch" ::: "memory"); \
    _Pragma("unroll") for (int d = 0; d < NCB; ++d) _Pragma("unroll") for (int r = 0; r < 16; ++r) o[d][r] *= (a); } } while (0)
  const int vbase = (int)(uintptr_t)(ldsl + G::KB) + v_rd_base(lane);
  DMA_TILE(0, 0); TILE_SYNC();
  for (int j = 0; j < NT; ++j) {
    const int b = j & 1;
    if (j + 1 < NT) DMA_TILE(b ^ 1, j + 1);
    const char* Ks = lds + b * G::BUF; const int vb = vbase + b * G::BUF;
    f32x16 p0, p1; float alpha; bf16x8 paA, paB;
    if (!mod.template skip<0>(j)) { qk_half<0>(p0, Ks, qr, r32, hi); mod.template apply<0>(p0, j); sm_half(p0, m_reg, l_reg, alpha, paA, paB); RESC(alpha); SBAR(); pv_half<NCB, 0>(o, vb, paA, paB); }
    if (!mod.template skip<1>(j)) { qk_half<1>(p1, Ks, qr, r32, hi); mod.template apply<1>(p1, j); sm_half(p1, m_reg, l_reg, alpha, paA, paB); RESC(alpha); SBAR(); pv_half<NCB, 2>(o, vb, paA, paB); }
    TILE_SYNC();
  }
  const float rl = __builtin_amdgcn_rcpf(l_reg);
  unsigned short* Orow = (unsigned short*)Ob + (long)(wid * QBLK + r32) * LDO + hi * 8;
#pragma unroll
  for (int d0 = 0; d0 < NCB; ++d0)
#pragma unroll
    for (int g = 0; g < 4; g += 2) {
      unsigned ax = cvtpk(o[d0][4 * g + 0] * rl, o[d0][4 * g + 1] * rl), ay = cvtpk(o[d0][4 * g + 2] * rl, o[d0][4 * g + 3] * rl);
      unsigned bx = cvtpk(o[d0][4 * g + 4] * rl, o[d0][4 * g + 5] * rl), by = cvtpk(o[d0][4 * g + 6] * rl, o[d0][4 * g + 7] * rl);
      auto rx = __builtin_amdgcn_permlane32_swap(ax, bx, false, false); auto ry = __builtin_amdgcn_permlane32_swap(ay, by, false, false);
      u32x4 w = {rx[0], ry[0], rx[1], ry[1]};
      *reinterpret_cast<u32x4*>(Orow + d0 * 32 + 8 * g) = w; }
#undef DMA_TILE
#undef TILE_SYNC
#undef RESC
}
template <int LDQ, int LDK, int LDO, class Mod>
__device__ __forceinline__ void attn_unit_dma_A(const bf16* __restrict__ Qb, const bf16* __restrict__ Kh, const bf16* __restrict__ Vh, bf16* __restrict__ Ob, int q0, int seq_tiles, float slope, float needC, const Mod& mod,
                                              __attribute__((address_space(3))) unsigned char* ldsl, volatile __attribute__((address_space(3))) float* red) {
  constexpr int NCB = 8;
  typedef __attribute__((address_space(3))) unsigned LU; typedef DmaGeo<NCB> G;
  const int tid = tid_fresh(), wid = __builtin_amdgcn_readfirstlane(tid >> 6), lane = tid & 63, r32 = lane & 31, hi = lane >> 5;
  char* lds = (char*)ldsl;
  float m_reg = mod.m_init(), l_reg = mod.l_init(); f32x16 o[NCB] = {}; bf16x8 qr[8];
  const bf16* Qw = Qb + (long)(wid * QBLK + r32) * LDQ + hi * 8;
#pragma unroll
  for (int d0 = 0; d0 < 8; ++d0) qr[d0] = *reinterpret_cast<const bf16x8*>(Qw + d0 * 16);
  const int krow = 4 * wid + (lane >> 4);
  const unsigned koff = (unsigned)(krow * LDK + (((lane & 15) ^ (krow & 7)) * 8)) * 2u;
  constexpr int PPK = NCB / 2, KSTEP = 64 / PPK;
  const int kk0 = (wid / PPK) * 8 + ((lane & 31) >> 2), vk0 = (kk0 & ~0xC) | ((kk0 & 4) << 1) | ((kk0 & 8) >> 1);
  const unsigned voff = (unsigned)(vk0 * LDK + ((2 * (wid % PPK) + (lane >> 5)) * 32 + (lane & 3) * 8)) * 2u;
  constexpr size_t TILE_B = (size_t)KVBLK * LDK * 2;
#define DMA_TILE(b, jt) do { const char* kg_ = (const char*)Kh + (size_t)(jt) * TILE_B; const char* vg_ = (const char*)Vh + (size_t)(jt) * TILE_B;                              \
    __builtin_amdgcn_global_load_lds((const unsigned*)(kg_ + koff), (LU*)(ldsl + (b) * G::BUF + wid * 1024), 16, 0, 0);                                                       \
    __builtin_amdgcn_global_load_lds((const unsigned*)(kg_ + koff + 32 * LDK * 2), (LU*)(ldsl + (b) * G::BUF + (wid + 8) * 1024), 16, 0, 0);                                  \
    _Pragma("unroll") for (int i_ = 0; i_ < PPK; ++i_)                                                                                                                        \
      __builtin_amdgcn_global_load_lds((const unsigned*)(vg_ + voff + i_ * KSTEP * LDK * 2), (LU*)(ldsl + (b) * G::BUF + G::KB + (wid + 8 * i_) * 1024), 16, 0, 0); } while (0)
#define TILE_SYNC() do { asm volatile("s_waitcnt vmcnt(0)" ::: "memory"); __syncthreads(); } while (0)
#define RESC(a) do { if (__any((a) < 1.f)) { asm volatile("; rescale (rare): keep this a real branch" ::: "memory"); \
    _Pragma("unroll") for (int d = 0; d < NCB; ++d) _Pragma("unroll") for (int r = 0; r < 16; ++r) o[d][r] *= (a); } } while (0)
  const int vbase = (int)(uintptr_t)(ldsl + G::KB) + v_rd_base(lane);
  const int tq = q0 >> 6;
  int c0 = tq - 1; c0 = c0 < 0 ? 0 : c0; int c1 = tq + 5; c1 = c1 > seq_tiles ? seq_tiles : c1;
  int L0 = 0, nL = 0, n = c1 - c0;
#define JT_(j) (seg == 0 ? c0 + (j) : ((j) < nL ? L0 + (j) : c1 + (j) - nL))
  for (int seg = 0; seg < 2; ++seg) {
    if (n > 0) {
      DMA_TILE(0, JT_(0)); TILE_SYNC();
      for (int j = 0; j < n; ++j) {
        const int b = j & 1;
        if (j + 1 < n) DMA_TILE(b ^ 1, JT_(j + 1));
        const int jt = JT_(j);
        const char* Ks = lds + b * G::BUF; const int vb = vbase + b * G::BUF;
        f32x16 p0, p1; float alpha; bf16x8 paA, paB;
        { qk_half<0>(p0, Ks, qr, r32, hi); mod.template apply<0>(p0, jt); sm_half(p0, m_reg, l_reg, alpha, paA, paB); RESC(alpha); SBAR(); pv_half<NCB, 0>(o, vb, paA, paB); }
        { qk_half<1>(p1, Ks, qr, r32, hi); mod.template apply<1>(p1, jt); sm_half(p1, m_reg, l_reg, alpha, paA, paB); RESC(alpha); SBAR(); pv_half<NCB, 2>(o, vb, paA, paB); }
        TILE_SYNC();
      }
    }
    if (seg == 0) {
      float lse = fmaf(m_reg, SCALE, __logf(l_reg));
#pragma unroll
      for (int o_ = 1; o_ < 64; o_ <<= 1) lse = fminf(lse, __shfl_xor(lse, o_));
      if (lane == 0) red[wid] = lse;
      __syncthreads();
      float lmin = red[0];
#pragma unroll
      for (int w_ = 1; w_ < 8; ++w_) lmin = fminf(lmin, red[w_]);
      __syncthreads();
      float d0f = (needC - lmin) / slope + 1.f; d0f = d0f < 0.f ? 0.f : d0f; const float smax = (float)(seq_tiles * 64);
      const int d0 = __builtin_amdgcn_readfirstlane(d0f > smax ? seq_tiles * 64 : (int)d0f);
      int klo = q0 - d0; klo = klo < 0 ? 0 : (klo >> 6);
      int khi = q0 + 256 + d0; khi = khi > seq_tiles * 64 ? seq_tiles : ((khi + 63) >> 6);
      L0 = klo; nL = c0 - klo; nL = nL < 0 ? 0 : nL;
      int nR = khi - c1; nR = nR < 0 ? 0 : nR;
      n = nL + nR;
    }
  }
#undef JT_
  const float rl = __builtin_amdgcn_rcpf(l_reg);
  unsigned short* Orow = (unsigned short*)Ob + (long)(wid * QBLK + r32) * LDO + hi * 8;
#pragma unroll
  for (int d0 = 0; d0 < NCB; ++d0)
#pragma unroll
    for (int g = 0; g < 4; g += 2) {
      unsigned ax = cvtpk(o[d0][4 * g + 0] * rl, o[d0][4 * g + 1] * rl), ay = cvtpk(o[d0][4 * g + 2] * rl, o[d0][4 * g + 3] * rl);
      unsigned bx = cvtpk(o[d0][4 * g + 4] * rl, o[d0][4 * g + 5] * rl), by = cvtpk(o[d0][4 * g + 6] * rl, o[d0][4 * g + 7] * rl);
      auto rx = __builtin_amdgcn_permlane32_swap(ax, bx, false, false); auto ry = __builtin_amdgcn_permlane32_swap(ay, by, false, false);
      u32x4 w = {rx[0], ry[0], rx[1], ry[1]};
      *reinterpret_cast<u32x4*>(Orow + d0 * 32 + 8 * g) = w; }
#undef DMA_TILE
#undef TILE_SYNC
#undef RESC
}
}
constexpr int NWAVES = 8;
constexpr int BATCH = 2, SEQ = 8192, DM = 2048, DFF = 5632, DEPTH = 4, HD = 128;
constexpr int M = BATCH * SEQ;
constexpr int LD2 = DM + 128, LDF = DFF + 128;
constexpr int LDQA = 6144 + 128, LDQC = 3072 + 128, LDOC = 4096 + 128;
constexpr int NGU = 2 * DFF;
constexpr float RMS_EPS = 1e-6f;
constexpr size_t MiB = 1u << 20;
constexpr size_t WS_CTL = 0, CTL_ZERO_BYTES = 1 * MiB;
constexpr size_t SZ_WGU = (size_t)NGU * LD2 * 2, SZ_WDN = (size_t)DM * LDF * 2, SZ_WQKV = (size_t)6144 * LD2 * 2, SZ_WO = (size_t)DM * LD2 * 2;
constexpr size_t WS_WGU = 2 * MiB;
constexpr size_t WS_WDN = WS_WGU + 8 * SZ_WGU;
constexpr size_t WS_WQKV = WS_WDN + 8 * SZ_WDN;
constexpr size_t WS_WO = WS_WQKV + 4 * SZ_WQKV;
constexpr size_t WS_H = WS_WO + 4 * SZ_WO;
constexpr size_t WS_ACT = WS_H + (size_t)M * LD2 * 2;
constexpr size_t WS_QKV = WS_ACT + (size_t)M * LDF * 2;
constexpr size_t WS_OC = WS_QKV + (size_t)M * LDQA * 2;
constexpr size_t WS_O = WS_OC + (size_t)M * LDOC * 2;
constexpr size_t WS_ROWSS = WS_O + (size_t)M * LD2 * 2;
constexpr size_t WS_END = WS_ROWSS + (size_t)12 * M * 32 * 4;
constexpr int CW_Q = 8192;
constexpr int CW_BAR = 4096;
constexpr int RING_OFF = 0, RING_BYTES = 131072;
constexpr int LDSCTL_OFF = RING_BYTES, MISC_OFF = LDSCTL_OFF + 320;
constexpr int RSTD_OFF = LDSCTL_OFF + 2048;
constexpr int QKN_OFF = LDSCTL_OFF + 4096;
constexpr int LDS_BYTES = 147456;
static_assert(att::A_LDS_BYTES <= RING_BYTES && att::TBL2_OFF + att::TBL_FLOATS * 4 <= RING_BYTES, "attention LDS inside the ring region");

#define GAS __attribute__((address_space(1)))
#define LAS __attribute__((address_space(3)))
typedef unsigned short bf16;
typedef unsigned v4u __attribute__((ext_vector_type(4)));
typedef unsigned v2u __attribute__((ext_vector_type(2)));
typedef float f32x4 __attribute__((ext_vector_type(4)));
typedef short bf16x8 __attribute__((ext_vector_type(8)));
#define LDS_WAIT() asm volatile("s_waitcnt lgkmcnt(0)" ::: "memory")
#define VM_WAIT() asm volatile("s_waitcnt vmcnt(0)" ::: "memory")
__device__ __forceinline__ unsigned pk2(float lo, float hi) { return pg8::cvt_pk_bf16(lo, hi); }
__device__ __forceinline__ float bflo(unsigned w) { return __uint_as_float(w << 16); }
__device__ __forceinline__ float bfhi(unsigned w) { return __uint_as_float(w & 0xffff0000u); }

#define XB_TMO      128
#define XB_XCNT(j)  (256  + 64 * (j))
#define XB_XSUB(j)  (1280 + 64 * (j))
#define XB_XGEN(j)  (2304 + 64 * (j))
#define XB_TOP      3328
#define XB_TOPGEN   3392
#define XCD_BAR_WORDS 3456
#define XB_SPIN_CAP (1u << 23)

__device__ __forceinline__ unsigned xb_ld(unsigned* p)              { return __hip_atomic_load(p, __ATOMIC_RELAXED, __HIP_MEMORY_SCOPE_AGENT); }
__device__ __forceinline__ unsigned xb_add(unsigned* p, unsigned v) { return __hip_atomic_fetch_add(p, v, __ATOMIC_RELAXED, __HIP_MEMORY_SCOPE_AGENT); }
__device__ __forceinline__ unsigned xb_xcc_id() { return (unsigned)__builtin_amdgcn_s_getreg((3 << 11) | 20) & 0xFu; }
#define XB_SPIN(cond, bar) do { unsigned _sp = 0; while (cond) { __builtin_amdgcn_s_sleep(1); \
    if ((++_sp & 255u) == 0u) { if (xb_ld(&(bar)[XB_TMO])) break; if (_sp > XB_SPIN_CAP) { atomicAdd(&(bar)[XB_TMO], 1u); break; } } } } while (0)

struct XcdBarrier {
    unsigned* bar; unsigned x;
    volatile LAS unsigned* st;
};

__device__ __forceinline__ XcdBarrier xcd_barrier_post(unsigned* bar, volatile LAS unsigned* st) {
    XcdBarrier b; b.bar = bar; b.x = xb_xcc_id(); b.st = st;
    if (threadIdx.x == 0) (void)xb_add(&bar[XB_XCNT(b.x)], 1u);
    return b;
}
__device__ __forceinline__ void xcd_barrier_complete(unsigned* bar, unsigned x, unsigned& nloc, unsigned& nx) {
    const unsigned G = gridDim.x * gridDim.y * gridDim.z;
    unsigned sum, cnt, mine, sp = 0u;
    for (;;) {
        sum = 0u; cnt = 0u; mine = 0u;
#pragma unroll
        for (unsigned j = 0; j < 16; ++j) { const unsigned c = xb_ld(&bar[XB_XCNT(j)]); sum += c; cnt += (c > 0u) ? 1u : 0u; mine = (j == x) ? c : mine; }
        if (sum == G) break;
        __builtin_amdgcn_s_sleep(1);
        if ((++sp & 255u) == 0u) { if (xb_ld(&bar[XB_TMO])) break; if (sp > XB_SPIN_CAP) { atomicAdd(&bar[XB_TMO], 1u); break; } }
    }
    nloc = mine > 0u ? mine : 1u; nx = cnt > 0u ? cnt : 1u;
}

__device__ __forceinline__ void xcd_barrier(const XcdBarrier& b) {
    asm volatile("s_waitcnt vmcnt(0)" ::: "memory");
    __syncthreads();
    if (threadIdx.x == 0) {
        unsigned* bar = b.bar;
        __builtin_amdgcn_s_waitcnt(0);
        unsigned nloc = b.st[0], nx = b.st[1];
        if (nloc == 0u) { xcd_barrier_complete(bar, b.x, nloc, nx); b.st[0] = nloc; b.st[1] = nx; }
        const unsigned old = xb_add(&bar[XB_XSUB(b.x)], 1u);
        const unsigned gen = old / nloc;
        if (old + 1u == (gen + 1u) * nloc) {
            __builtin_amdgcn_fence(__ATOMIC_RELEASE, "agent");
            asm volatile("s_waitcnt vmcnt(0)" ::: "memory");
            const unsigned og = xb_add(&bar[XB_TOP], 1u);
            const unsigned tg = og / nx;
            if (og + 1u == (tg + 1u) * nx) xb_add(&bar[XB_TOPGEN], 1u);
            else XB_SPIN(xb_ld(&bar[XB_TOPGEN]) == tg, bar);
            __builtin_amdgcn_fence(__ATOMIC_ACQUIRE, "agent");
            xb_add(&bar[XB_XGEN(b.x)], 1u);
            asm volatile("s_waitcnt vmcnt(0)" ::: "memory");
        } else {
            XB_SPIN(xb_ld(&bar[XB_XGEN(b.x)]) == gen, bar);
            __builtin_amdgcn_fence(__ATOMIC_ACQUIRE, "agent");
            asm volatile("s_waitcnt vmcnt(0)" ::: "memory");
        }
    }
    __syncthreads();
}

constexpr int PTR_OFF = LDSCTL_OFF + 1024;
constexpr int I_OUT = 29, I_WS = 30, N_PTRS = 31;
__device__ __forceinline__ unsigned long long tbl_u64(LAS unsigned char* lds, int i) {
    const unsigned long long v = ((volatile LAS unsigned long long*)(lds + PTR_OFF))[i];
    const unsigned lo = __builtin_amdgcn_readfirstlane((unsigned)v), hi = __builtin_amdgcn_readfirstlane((unsigned)(v >> 32));
    return ((unsigned long long)hi << 32) | lo;
}
__device__ __forceinline__ const float* tbl_in(LAS unsigned char* lds, int i) { return (const float*)(const GAS float*)tbl_u64(lds, i); }
__device__ __forceinline__ unsigned char* tbl_ws(LAS unsigned char* lds) { return (unsigned char*)(GAS unsigned char*)tbl_u64(lds, I_WS); }
struct Geo { int tid, lane, wave, vcu, G, gw, NGW; };
__device__ __forceinline__ Geo geo() { Geo g; g.tid = tid_fresh(); g.lane = g.tid & 63; g.wave = __builtin_amdgcn_readfirstlane(g.tid >> 6);
    g.G = gridDim.x; { const int bx = blockIdx.x; g.vcu = (g.G % 8 == 0) ? (bx % 8) * (g.G / 8) + bx / 8 : bx; } g.gw = g.vcu * NWAVES + g.wave; g.NGW = g.G * NWAVES; return g; }
__device__ __forceinline__ float wave_sum(float v) {
#pragma unroll
    for (int o = 1; o < 64; o <<= 1) v += __shfl_xor(v, o);
    return v;
}
__device__ __forceinline__ void p0_transpose_item(const float* W, const float* g, int K, int N, bf16* WT, int k0, int n0, int drow0, LAS float* scr, int lane) {
    const int ldw = K + 128;
    const int c = lane & 7;
    f32x4 ga = (f32x4){1.f, 1.f, 1.f, 1.f}, gb = ga;
    if (g) { ga = *(const GAS f32x4*)(g + k0 + 8 * c); gb = *(const GAS f32x4*)(g + k0 + 8 * c + 4); }
#pragma unroll 8
    for (int i = 0; i < 32; ++i) { const int kk = 2 * i + (lane >> 5); scr[kk * 33 + (lane & 31)] = __builtin_nontemporal_load(&W[(size_t)(k0 + kk) * N + n0 + (lane & 31)]); }
    LDS_WAIT(); asm volatile("" ::: "memory");
#pragma unroll
    for (int j = 0; j < 4; ++j) { const int n = (lane >> 3) + 8 * j; const LAS float* s = scr + (8 * c) * 33 + n;
        v4u o; o.x = pk2(s[0 * 33] * ga.x, s[1 * 33] * ga.y); o.y = pk2(s[2 * 33] * ga.z, s[3 * 33] * ga.w); o.z = pk2(s[4 * 33] * gb.x, s[5 * 33] * gb.y); o.w = pk2(s[6 * 33] * gb.z, s[7 * 33] * gb.w);
        *(GAS v4u*)(WT + (size_t)(drow0 + n) * ldw + k0 + 8 * c) = o; }
    LDS_WAIT(); asm volatile("" ::: "memory");
}
__device__ __forceinline__ void p0_plain(const float* W, const float* g, int K, int N, bf16* WT, int item, LAS float* scr, int lane) {
    const int nblk = N / 32, kb = item / nblk, nb = item % nblk;
    p0_transpose_item(W, g, K, N, WT, 64 * kb, 32 * nb, 32 * nb, scr, lane);
}
__device__ __forceinline__ void p0_gu(const float* W, const float* g, bf16* WT, int up, int item, LAS float* scr, int lane) {
    const int nblk = DFF / 32, kb = item / nblk, nb = item % nblk, n0 = 32 * nb;
    p0_transpose_item(W, g, DM, DFF, WT, 64 * kb, n0, (n0 >> 7) * 256 + up * 128 + (n0 & 127), scr, lane);
}

__device__ __forceinline__ void xcast_phase(const float* x, bf16* xb, float* rowss) {
    const Geo F = geo(); const int gw = F.gw, NGW = F.NGW;
    for (int m = gw; m < M; m += NGW) {
        const GAS f32x4* xr = (const GAS f32x4*)(x + (size_t)m * DM) + F.lane;
        f32x4 v[8]; float s = 0.f;
#pragma unroll
        for (int j = 0; j < 8; ++j) v[j] = xr[64 * j];
        GAS v2u* o8 = (GAS v2u*)(xb + (size_t)m * LD2) + F.lane;
#pragma unroll
        for (int j = 0; j < 8; ++j) { v2u w; w.x = pk2(v[j].x, v[j].y); w.y = pk2(v[j].z, v[j].w); o8[64 * j] = w;
            const float r0 = bflo(w.x), r1 = bfhi(w.x), r2 = bflo(w.y), r3 = bfhi(w.y); s += (r0 * r0 + r1 * r1) + (r2 * r2 + r3 * r3); }
        s = wave_sum(s);
        if (F.lane < 32) rowss[(size_t)m * 32 + F.lane] = F.lane == 0 ? s : 0.f;
    }
}
__device__ __forceinline__ void combineA_phase(const bf16* OC, bf16* O, float lam, float post, const float* sg) {
    const Geo F = geo(); const int gw = F.gw, NGW = F.NGW;
    const int half = F.lane >> 5, li = F.lane & 31;
    const f32x4 s0 = *((const GAS f32x4*)sg + 2 * li), s1 = *((const GAS f32x4*)sg + 2 * li + 1);
    for (int t = gw; t < M * 4; t += NGW) {
        const int task = t * 2 + half, row = task >> 3, h = task & 7;
        const v4u a = *(const GAS v4u*)(OC + (size_t)row * LDOC + (h * 2 + 0) * 256 + li * 8);
        const v4u b = *(const GAS v4u*)(OC + (size_t)row * LDOC + (h * 2 + 1) * 256 + li * 8);
        float d[8] = {bflo(a.x) - lam * bflo(b.x), bfhi(a.x) - lam * bfhi(b.x), bflo(a.y) - lam * bflo(b.y), bfhi(a.y) - lam * bfhi(b.y),
                      bflo(a.z) - lam * bflo(b.z), bfhi(a.z) - lam * bfhi(b.z), bflo(a.w) - lam * bflo(b.w), bfhi(a.w) - lam * bfhi(b.w)};
        float s = 0.f;
#pragma unroll
        for (int i = 0; i < 8; ++i) s += d[i] * d[i];
        s += __shfl_xor(s, 1); s += __shfl_xor(s, 2); s += __shfl_xor(s, 4); s += __shfl_xor(s, 8); s += __shfl_xor(s, 16);
        const float rs = post / sqrtf(s * (1.f / 256.f) + RMS_EPS);
        v4u o; o.x = pk2(d[0] * rs * s0.x, d[1] * rs * s0.y); o.y = pk2(d[2] * rs * s0.z, d[3] * rs * s0.w);
        o.z = pk2(d[4] * rs * s1.x, d[5] * rs * s1.y); o.w = pk2(d[6] * rs * s1.z, d[7] * rs * s1.w);
        *(GAS v4u*)(O + (size_t)row * LD2 + h * 256 + li * 8) = o;
    }
}

__device__ __forceinline__ int clampi(int v, int lo, int hi) { return v < lo ? lo : (v > hi ? hi : v); }
__device__ __forceinline__ void attnA_phase(const bf16* QKV, bf16* OC, const float* gq, const float* gk, unsigned* qctr, LAS unsigned char* ldsl) {
    const Geo F = geo();
    volatile LAS unsigned* slot = (volatile LAS unsigned*)(ldsl + MISC_OFF) + 16;
    float gmq = fmaxf(fabsf(gq[F.lane]), fabsf(gq[F.lane + 64])), gmk = fmaxf(fabsf(gk[F.lane]), fabsf(gk[F.lane + 64]));
#pragma unroll
    for (int o = 1; o < 64; o <<= 1) { gmq = fmaxf(gmq, __shfl_xor(gmq, o)); gmk = fmaxf(gmk, __shfl_xor(gmk, o)); }
    const float twoB = 2.f * gmq * gmk * att::ISCALE;
    const int qi = blockIdx.x & 7;
    unsigned* ctr = qctr + 64 * qi;
    unsigned* gctr = qctr + 8 * 64;
    bool own = true;
    for (;;) {
        if (F.tid == 0) {
            unsigned v = own ? __hip_atomic_fetch_add(ctr, 1u, __ATOMIC_RELAXED, __HIP_MEMORY_SCOPE_AGENT) : 64u;
            if (v >= 64u) v = 64u + __hip_atomic_fetch_add(gctr, 1u, __ATOMIC_RELAXED, __HIP_MEMORY_SCOPE_AGENT);
            slot[0] = v; }
        __syncthreads();
        const unsigned p = (unsigned)__builtin_amdgcn_readfirstlane((int)slot[0]);
        __syncthreads();
        if (p >= 64u + 512u) break;
        int h, bc, i;
        if (p < 64u) { const int r = p >> 5; i = p & 31; bc = qi >> 1; h = (qi & 1) == 0 ? (r == 0 ? 7 : 4) : (r == 0 ? 6 : 5); }
        else { own = false; const unsigned g = p - 64u; h = 3 - (int)(g >> 7); bc = (int)((g >> 5) & 3u); i = (int)(g & 31u); }
        const int qblk = (i & 1) ? 15 - (i >> 1) : 16 + (i >> 1);
        const int b = bc >> 1, c = bc & 1;
        const float slope = exp2f(-(float)(h + 1));
        const float needC = 0.5f * twoB + 30.f + logf(2.f / (expf(slope) - 1.f));
        const int q0 = qblk * 256;
        const size_t row0 = (size_t)b * SEQ;
        const bf16* Qb = QKV + (row0 + q0) * LDQA + (h * 2 + c) * 128;
        const bf16* Kh = QKV + row0 * LDQA + 2048 + (h * 2 + c) * 128;
        const bf16* Vh = QKV + row0 * LDQA + 4096 + h * 256;
        bf16* Ob = OC + (row0 + q0) * LDOC + (h * 2 + c) * 256;
        att::ModA2 mod; mod.slopeS = slope * att::ISCALE; mod.qk0 = q0 + (F.tid >> 6) * 32 + (F.lane & 31) - 4 * (F.lane >> 5);
        att::attn_unit_dma_A<LDQA, LDQA, LDOC, att::ModA2>((const att::bf16*)Qb, (const att::bf16*)Kh, (const att::bf16*)Vh, (att::bf16*)Ob, q0, SEQ / 64, slope, needC, mod, ldsl + RING_OFF,
                                                          (volatile LAS float*)(ldsl + MISC_OFF) + 24);
    }
}
__device__ __forceinline__ void attnB_phase(const bf16* QKV, bf16* O, const float* rel_bias, LAS unsigned char* ldsl) {
    const Geo F = geo(); const int wid = F.tid >> 6, r32 = F.lane & 31, hi = F.lane >> 5;
    float* tbl = (float*)((char*)(ldsl + RING_OFF) + att::TBL2_OFF);
    for (int uidx = F.vcu; uidx < 1024; uidx += F.G) {
        const int qblk = uidx & 31, combo = uidx >> 5, h = combo & 15, b = combo >> 4;
        const int r0 = qblk * 4, lo = clampi(r0 - 4, 0, 120), hi_ = clampi(r0 - 1, 0, 120) + 8; const int NT = hi_ - lo;
        const size_t row0 = (size_t)b * SEQ;
        const bf16* Qb = QKV + (row0 + qblk * 256) * LDQA + h * 128;
        const bf16* Kh = QKV + (row0 + lo * 64) * LDQA + 2048 + h * 128;
        const bf16* Vh = QKV + (row0 + lo * 64) * LDQA + 4096 + h * 128;
        bf16* Ob = O + (row0 + qblk * 256) * LD2 + h * 128;
        for (int i = F.tid; i < att::TBL_FLOATS; i += NWAVES * 64) { const int j = i - 64; tbl[i] = (j >= 0 && j < 465) ? rel_bias[h * 465 + j] * att::ISCALE : 0.f; }
        const int pos = qblk * 256 + wid * 32 + r32, r = pos >> 6, c = pos & 63;
        att::ModB2 mod; mod.tbl = tbl; mod.r = r; mod.r_start = clampi(r - 4, 0, 120); mod.kr0 = lo; mod.tb0 = 64 + 4 * hi - c + 15; mod.kc0 = 4 * hi - clampi(c - 8, 0, 48);
        { const int pw = qblk * 256 + wid * 32; mod.rs_u = __builtin_amdgcn_readfirstlane(clampi((pw >> 6) - 4, 0, 120)); mod.cw0 = __builtin_amdgcn_readfirstlane(pw & 63); }
        att::attn_unit_dma<4, LDQA, LDQA, LD2, att::ModB2>((const att::bf16*)Qb, (const att::bf16*)Kh, (const att::bf16*)Vh, (att::bf16*)Ob, NT, mod, ldsl + RING_OFF);
    }
}
__device__ __forceinline__ void attnC_phase(const bf16* QKV, bf16* O, const float* sink, LAS unsigned char* ldsl) {
    const Geo F = geo(); const int wid = __builtin_amdgcn_readfirstlane(F.tid >> 6), r32 = F.lane & 31, hi = F.lane >> 5;
    for (int uidx = F.vcu; uidx < 1024; uidx += F.G) {
        const int qb = uidx & 127, combo = uidx >> 7, g = combo & 3, b = combo >> 2, h = 4 * g + (wid >> 1);
        const int q0 = qb * 64, klo = q0 - 128 < 0 ? 0 : q0 - 128, khi = q0 + 192 > SEQ ? SEQ : q0 + 192, NT = (khi - klo) / 64;
        const int qw = q0 + (wid & 1) * 32;
        const size_t row0 = (size_t)b * SEQ;
        const bf16* Qb = QKV + ((long)row0 + qw - wid * 32) * LDQC + h * 128;
        const bf16* Kh = QKV + (row0 + klo) * LDQC + 2048 + g * 128;
        const bf16* Vh = QKV + (row0 + klo) * LDQC + 2560 + g * 128;
        bf16* Ob = O + ((long)row0 + qw - wid * 32) * LD2 + h * 128;
        att::ModC2 mod; mod.slopeS = exp2f(-0.5f * (float)(h + 1)) * att::ISCALE; mod.sinkS = sink[h] * att::ISCALE; mod.qk0 = qw + r32 - klo - 4 * hi; mod.qw0 = __builtin_amdgcn_readfirstlane(qw - klo);
        att::attn_unit_dma<4, LDQC, LDQC, LD2, att::ModC2>((const att::bf16*)Qb, (const att::bf16*)Kh, (const att::bf16*)Vh, (att::bf16*)Ob, NT, mod, ldsl + RING_OFF);
    }
}

__device__ __forceinline__ void ph_prologue(LAS unsigned char* lds) {
    const Geo F = geo();
    unsigned char* ws = tbl_ws(lds);
    bf16* const WGU = (bf16*)(ws + WS_WGU); bf16* const WDN = (bf16*)(ws + WS_WDN); bf16* const WQKV = (bf16*)(ws + WS_WQKV); bf16* const WO = (bf16*)(ws + WS_WO);
    LAS float* scr = (LAS float*)(lds + RING_OFF + F.wave * 16384);
    constexpr int IF = (DM / 64) * (DFF / 32);
    static_assert(IF == (DFF / 64) * (DM / 32), "item counts");
    for (int Li = 0; Li < DEPTH; ++Li) {
        const int L = DEPTH - 1 - Li;
        const int kind = L % 3, j = L / 3, nq = kind == 2 ? 3072 : 6144;
        const float* wqkv = kind == 0 ? tbl_in(lds, 10) + (size_t)j * DM * 6144 : tbl_in(lds, kind == 1 ? 19 : 24);
        const float* wo = kind == 0 ? tbl_in(lds, 18) + (size_t)j * DM * DM : tbl_in(lds, kind == 1 ? 23 : 28);
        const int IQ = (DM / 64) * (nq / 32), IO = (DM / 64) * (DM / 32), NIT = 6 * IF + IQ + IO;
        const size_t offF = (size_t)L * DM * DFF;
        bf16* gu1 = WGU + (size_t)(2 * L) * NGU * LD2; bf16* gu2 = gu1 + (size_t)NGU * LD2;
        bf16* dn1 = WDN + (size_t)(2 * L) * DM * LDF; bf16* dn2 = dn1 + (size_t)DM * LDF;
        for (int it = F.gw; it < NIT; it += F.NGW) {
            int r = NIT - 1 - it;
            if (r < IF) { p0_gu(tbl_in(lds, 2) + offF, tbl_in(lds, 1) + L * DM, gu1, 0, r, scr, F.lane); continue; } r -= IF;
            if (r < IF) { p0_gu(tbl_in(lds, 3) + offF, tbl_in(lds, 1) + L * DM, gu1, 1, r, scr, F.lane); continue; } r -= IF;
            if (r < IF) { p0_plain(tbl_in(lds, 4) + offF, nullptr, DFF, DM, dn1, r, scr, F.lane); continue; } r -= IF;
            if (r < IF) { p0_gu(tbl_in(lds, 7) + offF, tbl_in(lds, 6) + L * DM, gu2, 0, r, scr, F.lane); continue; } r -= IF;
            if (r < IF) { p0_gu(tbl_in(lds, 8) + offF, tbl_in(lds, 6) + L * DM, gu2, 1, r, scr, F.lane); continue; } r -= IF;
            if (r < IF) { p0_plain(tbl_in(lds, 9) + offF, nullptr, DFF, DM, dn2, r, scr, F.lane); continue; } r -= IF;
            if (r < IQ) { p0_plain(wqkv, tbl_in(lds, 5) + L * DM, DM, nq, WQKV + (size_t)L * 6144 * LD2, r, scr, F.lane); continue; } r -= IQ;
            p0_plain(wo, nullptr, DM, DM, WO + (size_t)L * DM * LD2, r, scr, F.lane);
        }
    }
    xcast_phase(tbl_in(lds, 0), (bf16*)(ws + WS_H), (float*)(ws + WS_ROWSS));
}
__device__ __forceinline__ int ver_ffn(int s) { return s + ((s + 1) >> 1); }
__device__ __forceinline__ float* rowss_of(unsigned char* ws, int v) { return (float*)(ws + WS_ROWSS) + (size_t)v * M * 32; }
__device__ __forceinline__ void ph_gemm_gu(LAS unsigned char* lds, int s) {
    unsigned char* ws = tbl_ws(lds); const int G = gridDim.x;
    pg8::Gemm g{(const bf16*)(ws + WS_H), (const bf16*)(ws + WS_WGU) + (size_t)s * NGU * LD2, M, NGU, DM, LD2, LD2}; pg8::StaticOrder S; S.init(M, NGU, G, (int)blockIdx.x);
    volatile LAS int* tag = (volatile LAS int*)(lds + MISC_OFF) + 20; if (threadIdx.x == 0) *tag = -1;
    pg8::EpiSwiGLU E{(bf16*)(ws + WS_ACT), LDF, pg8::RstdPanel{rowss_of(ws, ver_ffn(s)), (LAS float*)(lds + RSTD_OFF), tag}};
    pg8::gemm_phase<pg8::EpiSwiGLU, pg8::StaticOrder, true, true>(lds + RING_OFF, g, S, E);
}
__device__ __forceinline__ void ph_gemm_down(LAS unsigned char* lds, int s) {
    unsigned char* ws = tbl_ws(lds); const int G = gridDim.x;
    pg8::Gemm g{(const bf16*)(ws + WS_ACT), (const bf16*)(ws + WS_WDN) + (size_t)s * DM * LDF, M, DM, DFF, LDF, LDF}; pg8::StaticOrder S; S.init(M, DM, G, (int)blockIdx.x);
    const bool last = s == 2 * DEPTH - 1;
    pg8::EpiResid E{s == 0 ? tbl_in(lds, 0) : nullptr, (const bf16*)(ws + WS_H), last ? nullptr : (bf16*)(ws + WS_H), last ? (float*)tbl_in(lds, I_OUT) : nullptr, last ? nullptr : rowss_of(ws, ver_ffn(s) + 1), LD2, DM, 0.5f};
    pg8::gemm_phase<pg8::EpiResid, pg8::StaticOrder, true, true>(lds + RING_OFF, g, S, E);
}
__device__ __forceinline__ void ph_gemm_qkv(LAS unsigned char* lds, int L) {
    unsigned char* ws = tbl_ws(lds); const int G = gridDim.x; const int nq = (L % 3) == 2 ? 3072 : 6144;
    pg8::Gemm g{(const bf16*)(ws + WS_H), (const bf16*)(ws + WS_WQKV) + (size_t)L * 6144 * LD2, M, nq, DM, LD2, LD2}; pg8::StaticOrder S; S.init(M, nq, G, (int)blockIdx.x);
    const int kind = L % 3, j = L / 3;
    const float* gq = tbl_in(lds, kind == 0 ? 11 : (kind == 1 ? 20 : 25)) + (kind == 0 ? j * HD : 0);
    const float* gk = tbl_in(lds, kind == 0 ? 12 : (kind == 1 ? 21 : 26)) + (kind == 0 ? j * HD : 0);
    volatile LAS int* tag = (volatile LAS int*)(lds + MISC_OFF) + 20; if (threadIdx.x == 0) *tag = -1;
    pg8::EpiQKV E{(bf16*)(ws + WS_QKV), nq + 128, pg8::RstdPanel{rowss_of(ws, 3 * L + 1), (LAS float*)(lds + RSTD_OFF), tag}, gq, gk, kind == 2 ? 4 : 16, (LAS float*)(lds + QKN_OFF)};
    pg8::gemm_phase<pg8::EpiQKV, pg8::StaticOrder, true, true>(lds + RING_OFF, g, S, E);
}
__device__ __forceinline__ void ph_gemm_wo(LAS unsigned char* lds, int L) {
    unsigned char* ws = tbl_ws(lds); const int G = gridDim.x;
    pg8::Gemm g{(const bf16*)(ws + WS_O), (const bf16*)(ws + WS_WO) + (size_t)L * DM * LD2, M, DM, DM, LD2, LD2}; pg8::StaticOrder S; S.init(M, DM, G, (int)blockIdx.x);
    pg8::EpiResid E{nullptr, (const bf16*)(ws + WS_H), (bf16*)(ws + WS_H), nullptr, rowss_of(ws, 3 * L + 2), LD2, DM, 1.0f};
    pg8::gemm_phase<pg8::EpiResid, pg8::StaticOrder, true, true>(lds + RING_OFF, g, S, E);
}
__device__ __forceinline__ void ph_combineA(LAS unsigned char* lds, int L) {
    unsigned char* ws = tbl_ws(lds); const int j = L / 3, lane = threadIdx.x & 63;
    const float lambda_init = 0.8f - 0.6f * expf(-0.3f * (float)L);
    const float* lq1 = tbl_in(lds, 13) + j * HD; const float* lk1 = tbl_in(lds, 14) + j * HD; const float* lq2 = tbl_in(lds, 15) + j * HD; const float* lk2 = tbl_in(lds, 16) + j * HD;
    const float s1 = wave_sum(lq1[lane] * lk1[lane] + lq1[lane + 64] * lk1[lane + 64]);
    const float s2 = wave_sum(lq2[lane] * lk2[lane] + lq2[lane + 64] * lk2[lane + 64]);
    const float lam = expf(s1) - expf(s2) + lambda_init;
    combineA_phase((const bf16*)(ws + WS_OC), (bf16*)(ws + WS_O), lam, 1.0f - lambda_init, tbl_in(lds, 17) + j * 256);
}

struct Args { const float* in[29]; float* out; unsigned char* ws; };
__global__ void __launch_bounds__(NWAVES * 64, 2) fwd(Args args) {
    extern __shared__ __attribute__((aligned(16))) unsigned char lds_raw[];
    LAS unsigned char* lds = (LAS unsigned char*)lds_raw;
    {   const int tid = threadIdx.x;
        for (int u = tid; u < (LDS_BYTES - LDSCTL_OFF) / 4; u += NWAVES * 64) ((LAS unsigned*)(lds + LDSCTL_OFF))[u] = 0u;
        __syncthreads();
        if (tid == 0) { LAS unsigned long long* t = (LAS unsigned long long*)(lds + PTR_OFF);
#pragma unroll
            for (int i = 0; i < 29; ++i) t[i] = (unsigned long long)args.in[i];
            t[I_OUT] = (unsigned long long)args.out; t[I_WS] = (unsigned long long)args.ws; }
        __syncthreads();
    }
    { volatile LAS unsigned* MISC = (volatile LAS unsigned*)(lds + MISC_OFF); (void)xcd_barrier_post((unsigned*)tbl_ws(lds) + CW_BAR, MISC + 8); }
#define GRID_BAR() do { XcdBarrier b_; b_.bar = (unsigned*)tbl_ws(lds) + CW_BAR; b_.x = xb_xcc_id(); b_.st = (volatile LAS unsigned*)(lds + MISC_OFF) + 8; xcd_barrier(b_); } while (0)

    ph_prologue(lds);
    GRID_BAR();
    for (int s = 0; s < 2 * DEPTH; ++s) {
        const int L = s >> 1;
        ph_gemm_gu(lds, s);
        GRID_BAR();
        ph_gemm_down(lds, s);
        if (s == 2 * DEPTH - 1) break;
        GRID_BAR();
        if ((s & 1) == 0) {
            const int kind = L % 3;
            ph_gemm_qkv(lds, L);
            GRID_BAR();
            if (kind == 0) {
#ifndef NO_A
                { unsigned char* ws = tbl_ws(lds); const int j_ = L / 3; attnA_phase((const bf16*)(ws + WS_QKV), (bf16*)(ws + WS_OC), tbl_in(lds, 11) + j_ * HD, tbl_in(lds, 12) + j_ * HD, (unsigned*)ws + CW_Q + j_ * 16 * 64, lds); }
#endif
                GRID_BAR();
                ph_combineA(lds, L);
            } else if (kind == 1) {
#ifndef NO_B
                { unsigned char* ws = tbl_ws(lds); attnB_phase((const bf16*)(ws + WS_QKV), (bf16*)(ws + WS_O), tbl_in(lds, 22), lds); }
#endif
            } else {
#ifndef NO_C
                { unsigned char* ws = tbl_ws(lds); attnC_phase((const bf16*)(ws + WS_QKV), (bf16*)(ws + WS_O), tbl_in(lds, 27), lds); }
#endif
            }
            GRID_BAR();
            ph_gemm_wo(lds, L);
            GRID_BAR();
        }
    }
}

extern "C" void kernel_launch(void* const* d_in, const int* in_sizes, int n_in, void* d_out, int out_size, void* d_ws, size_t ws_size, hipStream_t stream) {
    static int grid = 0;
    if (grid == 0) {
        if (n_in != 29 || in_sizes[0] != M * DM || out_size != M * DM || ws_size < WS_END) { fprintf(stderr, "kernel_launch: shape/workspace mismatch (n_in %d, ws %zu, need %zu); nothing launched\n", n_in, ws_size, (size_t)WS_END); grid = -1; return; }
        int dev = 0, cus = 0, per_cu = 0;
        if (hipGetDevice(&dev) != hipSuccess || hipDeviceGetAttribute(&cus, hipDeviceAttributeMultiprocessorCount, dev) != hipSuccess) { grid = -1; return; }
        if (hipFuncSetAttribute((const void*)fwd, hipFuncAttributeMaxDynamicSharedMemorySize, LDS_BYTES) != hipSuccess) { fprintf(stderr, "kernel_launch: hipFuncSetAttribute failed\n"); grid = -1; return; }
        if (hipOccupancyMaxActiveBlocksPerMultiprocessor(&per_cu, (const void*)fwd, NWAVES * 64, LDS_BYTES) != hipSuccess || per_cu < 1) fprintf(stderr, "kernel_launch: occupancy query reports %d\n", per_cu);
        (void)hipGetLastError();
        grid = cus;
    }
    if (grid < 0) return;
    if (hipMemsetAsync((char*)d_ws + WS_CTL, 0, CTL_ZERO_BYTES, stream) != hipSuccess) return;
    Args a{};
    for (int i = 0; i < 29; ++i) a.in[i] = (const float*)d_in[i];
    a.out = (float*)d_out; a.ws = (unsigned char*)d_ws;
    hipLaunchKernelGGL(fwd, dim3(grid), dim3(NWAVES * 64), LDS_BYTES, stream, a);
    const hipError_t le = hipPeekAtLastError();
    if (le != hipSuccess) fprintf(stderr, "kernel_launch: launch failed: %s\n", hipGetErrorName(le));
}
```

```cpp
#include <hip/hip_runtime.h>
#include <hip/hip_bf16.h>
#include <cstdio>
#include <cstdint>
#include <cmath>
__device__ __forceinline__ int tid_fresh() { int t = threadIdx.x; asm volatile("" : "+v"(t)); return t; }
namespace pg8 {
#define PG8_LAS __attribute__((address_space(3)))
typedef unsigned short bf16_t;
typedef short bf16x8 __attribute__((ext_vector_type(8)));
typedef float f32x4 __attribute__((ext_vector_type(4)));
typedef unsigned u32x4 __attribute__((ext_vector_type(4)));
constexpr int BM = 256, BK = 64, HALF = 128, HTB = HALF * BK * 2  , STAGE_BYTES = 8 * HTB, NXCD = 8, WGM = 8;

__host__ __device__ __forceinline__ int lds_byte(int r, int c) { const int st = (r >> 4) * 2 + (c >> 5), rr = r & 15, cc = c & 31, ob = rr * 64 + cc * 2; return st * 1024 + (ob ^ (((ob >> 9) & 1) << 5)); }
__host__ __device__ __forceinline__ void stage_rc(int b, int& R, int& C) { const int st = b / 1024, sb = b % 1024, swz = sb ^ (((sb >> 9) & 1) << 5); R = (st >> 1) * 16 + swz / 64; C = (st & 1) * 32 + (swz % 64) / 2; }
__host__ __device__ __forceinline__ int perm32(int rho) { const int n = rho >> 4, i = rho & 15; return 8 * (i >> 2) + 4 * n + (i & 3); }

struct Unit { int pm, pn; };
struct Gemm { const bf16_t* A; const bf16_t* Bt; int M, N, K, lda, ldb; };

struct StaticOrder {
    int nM, nN, nwg, G, c;
    __host__ __device__ void init(int M, int N, int G_, int c_) { nM = M / BM; nN = N / BM; nwg = nM * nN; G = G_; c = c_; }
    __host__ __device__ bool next(int i, Unit& u) const {
        const long L = (long)i * G + c; if (L >= nwg) return false;
        int wgid = (int)L; { const int q = nwg / NXCD, r = nwg % NXCD, xcd = wgid % NXCD, off = wgid / NXCD; wgid = (xcd < r ? xcd * (q + 1) : r * (q + 1) + (xcd - r) * q) + off; }
        const int nig = WGM * nN, gid = wgid / nig, fm = gid * WGM, gsz = (nM - fm) < WGM ? (nM - fm) : WGM;
        u.pm = fm + ((wgid % nig) % gsz); u.pn = (wgid % nig) / gsz; return true;
    }
    __device__ __forceinline__ void a_ready(const Unit&) const {}
    __device__ __forceinline__ void done(const Unit&) const {}
};


__device__ __forceinline__ unsigned cvt_pk_bf16(float lo, float hi) { unsigned r; asm volatile("v_cvt_pk_bf16_f32 %0, %1, %2" : "=v"(r) : "v"(lo), "v"(hi)); return r; }

constexpr float PG8_EPS = 1e-6f;
struct RstdPanel {
    const float* rowss; PG8_LAS float* tab; volatile PG8_LAS int* tag;
    __device__ __forceinline__ void ensure(int pm, int tid) const {
        const int have = __builtin_amdgcn_readfirstlane(*tag);
        if (have != pm) {
            asm volatile("s_waitcnt lgkmcnt(0)" ::: "memory"); __builtin_amdgcn_s_barrier(); asm volatile("" ::: "memory");
            if (tid < BM) { const f32x4* p = (const f32x4*)(rowss + (size_t)(pm * BM + tid) * 32); f32x4 v[8];
#pragma unroll
                for (int i = 0; i < 8; ++i) v[i] = p[i];
                float s = 0.f;
#pragma unroll
                for (int i = 0; i < 8; ++i) s += (v[i][0] + v[i][1]) + (v[i][2] + v[i][3]);
                tab[tid] = 1.0f / sqrtf(s * (1.0f / 2048.0f) + PG8_EPS); }
            if (tid == 0) *tag = pm;
            asm volatile("s_waitcnt lgkmcnt(0)" ::: "memory"); __builtin_amdgcn_s_barrier(); asm volatile("" ::: "memory");
        }
    }
    __device__ __forceinline__ void rows(int wr, int fr, float (&rs)[2][4]) const {
#pragma unroll
        for (int ai = 0; ai < 2; ++ai)
#pragma unroll
            for (int m = 0; m < 4; ++m) rs[ai][m] = tab[ai * HALF + wr * 64 + m * 16 + fr];
    }
};

__device__ __forceinline__ float xsum4(float v) {
    { auto r = __builtin_amdgcn_permlane16_swap(__float_as_uint(v), __float_as_uint(v), false, false); v = __uint_as_float(r[0]) + __uint_as_float(r[1]); }
    { auto r = __builtin_amdgcn_permlane32_swap(__float_as_uint(v), __float_as_uint(v), false, false); v = __uint_as_float(r[0]) + __uint_as_float(r[1]); }
    return v;
}
struct EpiQKV {
    static constexpr bool PERM = true, AFTER_DRAIN = false;
    bf16_t* O; int ldc; RstdPanel rp; const float* gq; const float* gk; int nk; PG8_LAS float* P;
    __device__ __forceinline__ void operator()(const f32x4 (&acc)[2][2][4][2], const Unit& u, int wr, int wc, int fr, int fq) const {
        const int row0 = u.pm * BM + wr * 64 + fr, col0 = u.pn * BM + wc * 32 + 8 * fq;
        float rs[2][4]; rp.ensure(u.pm, (wr * 4 + wc) * 64 + fq * 16 + fr); rp.rows(wr, fr, rs);
        const int cls = u.pn < 8 ? 0 : (u.pn < 8 + (nk >> 1) ? 1 : 2);
        if (cls == 2) {
#pragma unroll
            for (int ai = 0; ai < 2; ++ai)
#pragma unroll
                for (int m = 0; m < 4; ++m) { bf16_t* rowp = O + (size_t)(row0 + ai * HALF + m * 16) * ldc + col0; const float r = rs[ai][m];
#pragma unroll
                    for (int bj = 0; bj < 2; ++bj) { const f32x4 v0 = acc[ai][bj][m][0] * r, v1 = acc[ai][bj][m][1] * r;
                        u32x4 w; w.x = cvt_pk_bf16(v0[0], v0[1]); w.y = cvt_pk_bf16(v0[2], v0[3]); w.z = cvt_pk_bf16(v1[0], v1[1]); w.w = cvt_pk_bf16(v1[2], v1[3]);
                        *(u32x4*)(rowp + bj * HALF) = w; } }
        } else {
            const float* g = cls == 0 ? gq : gk;
            const f32x4 g0 = *(const f32x4*)(g + wc * 32 + 8 * fq), g1 = *(const f32x4*)(g + wc * 32 + 8 * fq + 4);
#pragma unroll
            for (int ai = 0; ai < 2; ++ai)
#pragma unroll
                for (int m = 0; m < 4; ++m) { const float r = rs[ai][m];
#pragma unroll
                    for (int bj = 0; bj < 2; ++bj) { const f32x4 v0 = acc[ai][bj][m][0] * r, v1 = acc[ai][bj][m][1] * r;
                        float s = ((v0[0] * v0[0] + v0[1] * v0[1]) + (v0[2] * v0[2] + v0[3] * v0[3])) + ((v1[0] * v1[0] + v1[1] * v1[1]) + (v1[2] * v1[2] + v1[3] * v1[3]));
                        s += __shfl_xor(s, 16); s += __shfl_xor(s, 32);
                        if (fq == 0) P[((ai * HALF + wr * 64 + m * 16 + fr) * 2 + bj) * 4 + wc] = s; } }
            asm volatile("s_waitcnt lgkmcnt(0)" ::: "memory"); __builtin_amdgcn_s_barrier(); asm volatile("" ::: "memory");
#pragma unroll
            for (int ai = 0; ai < 2; ++ai)
#pragma unroll
                for (int m = 0; m < 4; ++m) { bf16_t* rowp = O + (size_t)(row0 + ai * HALF + m * 16) * ldc + col0; const float r = rs[ai][m];
#pragma unroll
                    for (int bj = 0; bj < 2; ++bj) { const f32x4 t = *(const PG8_LAS f32x4*)(P + ((ai * HALF + wr * 64 + m * 16 + fr) * 2 + bj) * 4);
                        const float rn = r / sqrtf(((t[0] + t[1]) + (t[2] + t[3])) * (1.0f / 128.0f) + PG8_EPS);
                        const f32x4 v0 = acc[ai][bj][m][0] * rn * g0, v1 = acc[ai][bj][m][1] * rn * g1;
                        u32x4 w; w.x = cvt_pk_bf16(v0[0], v0[1]); w.y = cvt_pk_bf16(v0[2], v0[3]); w.z = cvt_pk_bf16(v1[0], v1[1]); w.w = cvt_pk_bf16(v1[2], v1[3]);
                        *(u32x4*)(rowp + bj * HALF) = w; } }
        }
    }
};
__device__ __forceinline__ float silu_mul(float g, float u) { const float e = __builtin_amdgcn_exp2f(g * -1.4426950408889634f); return g * __builtin_amdgcn_rcpf(1.0f + e) * u; }
struct EpiSwiGLU {
    static constexpr bool PERM = true, AFTER_DRAIN = false;
    bf16_t* O; int ldc; RstdPanel rp;
    __device__ __forceinline__ void operator()(const f32x4 (&acc)[2][2][4][2], const Unit& u, int wr, int wc, int fr, int fq) const {
        const int row0 = u.pm * BM + wr * 64 + fr, col0 = u.pn * HALF + wc * 32 + 8 * fq;
        float rs[2][4]; rp.ensure(u.pm, (wr * 4 + wc) * 64 + fq * 16 + fr); rp.rows(wr, fr, rs);
#pragma unroll
        for (int ai = 0; ai < 2; ++ai)
#pragma unroll
            for (int m = 0; m < 4; ++m) { bf16_t* rowp = O + (size_t)(row0 + ai * HALF + m * 16) * ldc + col0; const float r = rs[ai][m];
                const float rn = r * -1.4426950408889634f, r2 = r * r;
                const f32x4 g0 = acc[ai][0][m][0], g1 = acc[ai][0][m][1], u0 = acc[ai][1][m][0], u1 = acc[ai][1][m][1];
#define SWG_(G, U) ((G) * (U)) * (r2 * __builtin_amdgcn_rcpf(1.0f + __builtin_amdgcn_exp2f((G) * rn)))
                u32x4 w; w.x = cvt_pk_bf16(SWG_(g0[0], u0[0]), SWG_(g0[1], u0[1])); w.y = cvt_pk_bf16(SWG_(g0[2], u0[2]), SWG_(g0[3], u0[3]));
                w.z = cvt_pk_bf16(SWG_(g1[0], u1[0]), SWG_(g1[1], u1[1])); w.w = cvt_pk_bf16(SWG_(g1[2], u1[2]), SWG_(g1[3], u1[3]));
#undef SWG_
                *(u32x4*)rowp = w; }
    }
};
struct EpiResid {
    static constexpr bool PERM = true, AFTER_DRAIN = false;
    const float* base32; const bf16_t* xin; bf16_t* xb; float* out32; float* rowss; int ldc, ld32; float alpha;
    __device__ __forceinline__ void operator()(const f32x4 (&acc)[2][2][4][2], const Unit& u, int wr, int wc, int fr, int fq) const {
        const int row0 = u.pm * BM + wr * 64 + fr, col0 = u.pn * BM + wc * 32 + 8 * fq;
        if (!base32 && !out32 && xb && rowss) {
#pragma unroll
            for (int ai = 0; ai < 2; ++ai) {
            u32x4 xw[1][4][2];
#pragma unroll
                for (int m = 0; m < 4; ++m)
#pragma unroll
                    for (int bj = 0; bj < 2; ++bj) xw[0][m][bj] = *(const u32x4*)(xin + (size_t)(row0 + ai * HALF + m * 16) * ldc + col0 + bj * HALF);
#pragma unroll
                for (int m = 0; m < 4; ++m) { const int row = row0 + ai * HALF + m * 16; const size_t off = (size_t)row * ldc + col0; float ss = 0.f;
#pragma unroll
                    for (int bj = 0; bj < 2; ++bj) { const u32x4 w0 = xw[0][m][bj];
                        const f32x4 b0 = (f32x4){__uint_as_float(w0.x << 16), __uint_as_float(w0.x & 0xffff0000u), __uint_as_float(w0.y << 16), __uint_as_float(w0.y & 0xffff0000u)};
                        const f32x4 b1 = (f32x4){__uint_as_float(w0.z << 16), __uint_as_float(w0.z & 0xffff0000u), __uint_as_float(w0.w << 16), __uint_as_float(w0.w & 0xffff0000u)};
                        const f32x4 o0 = b0 + acc[ai][bj][m][0] * alpha, o1 = b1 + acc[ai][bj][m][1] * alpha;
                        u32x4 w; w.x = cvt_pk_bf16(o0[0], o0[1]); w.y = cvt_pk_bf16(o0[2], o0[3]); w.z = cvt_pk_bf16(o1[0], o1[1]); w.w = cvt_pk_bf16(o1[2], o1[3]);
                        *(u32x4*)(xb + off + bj * HALF) = w;
                        const float r0 = __uint_as_float(w.x << 16), r1 = __uint_as_float(w.x & 0xffff0000u), r2 = __uint_as_float(w.y << 16), r3 = __uint_as_float(w.y & 0xffff0000u);
                        const float r4 = __uint_as_float(w.z << 16), r5 = __uint_as_float(w.z & 0xffff0000u), r6 = __uint_as_float(w.w << 16), r7 = __uint_as_float(w.w & 0xffff0000u);
                        ss += ((r0 * r0 + r1 * r1) + (r2 * r2 + r3 * r3)) + ((r4 * r4 + r5 * r5) + (r6 * r6 + r7 * r7)); }
                    ss = xsum4(ss); if (fq == 0) rowss[(size_t)row * 32 + u.pn * 4 + wc] = ss; }
            }
            return;
        }
        if (base32 && !out32 && xb && rowss) {
#pragma unroll
            for (int ai = 0; ai < 2; ++ai)
#pragma unroll
                for (int mp = 0; mp < 2; ++mp) {
                    f32x4 bb[2][2][2];
#pragma unroll
                    for (int mm = 0; mm < 2; ++mm)
#pragma unroll
                        for (int bj = 0; bj < 2; ++bj) { const float* p = base32 + (size_t)(row0 + ai * HALF + (2 * mp + mm) * 16) * ld32 + col0 + bj * HALF; bb[mm][bj][0] = *(const f32x4*)p; bb[mm][bj][1] = *(const f32x4*)(p + 4); }
#pragma unroll
                    for (int mm = 0; mm < 2; ++mm) { const int m = 2 * mp + mm, row = row0 + ai * HALF + m * 16; const size_t off = (size_t)row * ldc + col0; float ss = 0.f;
#pragma unroll
                        for (int bj = 0; bj < 2; ++bj) {
                            const f32x4 o0 = bb[mm][bj][0] + acc[ai][bj][m][0] * alpha, o1 = bb[mm][bj][1] + acc[ai][bj][m][1] * alpha;
                            u32x4 w; w.x = cvt_pk_bf16(o0[0], o0[1]); w.y = cvt_pk_bf16(o0[2], o0[3]); w.z = cvt_pk_bf16(o1[0], o1[1]); w.w = cvt_pk_bf16(o1[2], o1[3]);
                            *(u32x4*)(xb + off + bj * HALF) = w;
                            const float r0 = __uint_as_float(w.x << 16), r1 = __uint_as_float(w.x & 0xffff0000u), r2 = __uint_as_float(w.y << 16), r3 = __uint_as_float(w.y & 0xffff0000u);
                            const float r4 = __uint_as_float(w.z << 16), r5 = __uint_as_float(w.z & 0xffff0000u), r6 = __uint_as_float(w.w << 16), r7 = __uint_as_float(w.w & 0xffff0000u);
                            ss += ((r0 * r0 + r1 * r1) + (r2 * r2 + r3 * r3)) + ((r4 * r4 + r5 * r5) + (r6 * r6 + r7 * r7)); }
                        ss = xsum4(ss); if (fq == 0) rowss[(size_t)row * 32 + u.pn * 4 + wc] = ss; }
                }
            return;
        }
        if (!base32 && out32 && !xb && !rowss) {
#pragma unroll
            for (int ai = 0; ai < 2; ++ai) {
                u32x4 xw[4][2];
#pragma unroll
                for (int m = 0; m < 4; ++m)
#pragma unroll
                    for (int bj = 0; bj < 2; ++bj) xw[m][bj] = *(const u32x4*)(xin + (size_t)(row0 + ai * HALF + m * 16) * ldc + col0 + bj * HALF);
#pragma unroll
                for (int m = 0; m < 4; ++m) { const size_t off32 = (size_t)(row0 + ai * HALF + m * 16) * ld32 + col0;
#pragma unroll
                    for (int bj = 0; bj < 2; ++bj) { const u32x4 w0 = xw[m][bj];
                        const f32x4 b0 = (f32x4){__uint_as_float(w0.x << 16), __uint_as_float(w0.x & 0xffff0000u), __uint_as_float(w0.y << 16), __uint_as_float(w0.y & 0xffff0000u)};
                        const f32x4 b1 = (f32x4){__uint_as_float(w0.z << 16), __uint_as_float(w0.z & 0xffff0000u), __uint_as_float(w0.w << 16), __uint_as_float(w0.w & 0xffff0000u)};
                        *(f32x4*)(out32 + off32 + bj * HALF) = b0 + acc[ai][bj][m][0] * alpha; *(f32x4*)(out32 + off32 + bj * HALF + 4) = b1 + acc[ai][bj][m][1] * alpha; } }
            }
            return;
        }
#pragma unroll
        for (int ai = 0; ai < 2; ++ai)
#pragma unroll
            for (int m = 0; m < 4; ++m) { const int row = row0 + ai * HALF + m * 16; const size_t off = (size_t)row * ldc + col0, off32 = (size_t)row * ld32 + col0; float ss = 0.f;
#pragma unroll
                for (int bj = 0; bj < 2; ++bj) { f32x4 b0, b1;
                    if (base32) { b0 = *(const f32x4*)(base32 + off32 + bj * HALF); b1 = *(const f32x4*)(base32 + off32 + bj * HALF + 4); }
                    else { const u32x4 w = *(const u32x4*)(xin + off + bj * HALF);
                        b0 = (f32x4){__uint_as_float(w.x << 16), __uint_as_float(w.x & 0xffff0000u), __uint_as_float(w.y << 16), __uint_as_float(w.y & 0xffff0000u)};
                        b1 = (f32x4){__uint_as_float(w.z << 16), __uint_as_float(w.z & 0xffff0000u), __uint_as_float(w.w << 16), __uint_as_float(w.w & 0xffff0000u)}; }
                    const f32x4 o0 = b0 + acc[ai][bj][m][0] * alpha, o1 = b1 + acc[ai][bj][m][1] * alpha;
                    u32x4 w; w.x = cvt_pk_bf16(o0[0], o0[1]); w.y = cvt_pk_bf16(o0[2], o0[3]); w.z = cvt_pk_bf16(o1[0], o1[1]); w.w = cvt_pk_bf16(o1[2], o1[3]);
                    if (xb) *(u32x4*)(xb + off + bj * HALF) = w;
                    if (out32) { *(f32x4*)(out32 + off32 + bj * HALF) = o0; *(f32x4*)(out32 + off32 + bj * HALF + 4) = o1; }
                    const float r0 = __uint_as_float(w.x << 16), r1 = __uint_as_float(w.x & 0xffff0000u), r2 = __uint_as_float(w.y << 16), r3 = __uint_as_float(w.y & 0xffff0000u);
                    const float r4 = __uint_as_float(w.z << 16), r5 = __uint_as_float(w.z & 0xffff0000u), r6 = __uint_as_float(w.w << 16), r7 = __uint_as_float(w.w & 0xffff0000u);
                    ss += ((r0 * r0 + r1 * r1) + (r2 * r2 + r3 * r3)) + ((r4 * r4 + r5 * r5) + (r6 * r6 + r7 * r7)); }
                if (rowss) { ss = xsum4(ss); if (fq == 0) rowss[(size_t)row * 32 + u.pn * 4 + wc] = ss; }
                if (m & 1) asm volatile("" ::: "memory"); }
    }
};

template <class Epi, class Sched, bool ALIGN_EPI = false, bool SP2 = false>
__device__ __forceinline__ void gemm_phase(PG8_LAS unsigned char* lds, const Gemm g, const Sched& S, const Epi& E) {
    const int tid = tid_fresh(), wid = __builtin_amdgcn_readfirstlane(tid >> 6), lane = tid & 63, wr = wid >> 2, wc = wid & 3, fr = lane & 15, fq = lane >> 4;
    const int K = g.K, nt = K / BK;
    unsigned voffA[2], voffB[2];
#pragma unroll
    for (int i = 0; i < 2; ++i) { int R, C; stage_rc(tid * 16 + i * 8192, R, C); const int Rb = Epi::PERM ? ((R & ~31) + perm32(R & 31)) : R;
        voffA[i] = (unsigned)(R * g.lda + C) * 2u; voffB[i] = (unsigned)(Rb * g.ldb + C) * 2u; }
    const size_t kstep = (size_t)(BK * 2);
    const size_t hstepA = (size_t)HALF * g.lda * 2, hstepB = (size_t)HALF * g.ldb * 2;
    const size_t tstepA = 2 * hstepA, tstepB = 2 * hstepB;
    const unsigned ldsw = (unsigned)wid * 1024u;
    const int aoff = lds_byte(wr * 64 + fr, fq * 8), boff = lds_byte(wc * 32 + fr, fq * 8);
#define PG8_SA(b, h) (((b) * 2 + (h)) * HTB)
#define PG8_SB(b, h) ((4 + (b) * 2 + (h)) * HTB)
#define PG8_STAGE(bufoff, gbase, voff) do { _Pragma("unroll") for (int _i = 0; _i < 2; ++_i) \
        __builtin_amdgcn_global_load_lds((const unsigned*)((const char*)(gbase) + (voff)[_i]), (PG8_LAS unsigned*)(lds + (bufoff) + ldsw + _i * 8192), 16, 0, 0); } while (0)
#define PG8_LDA(dst, b, h) do { _Pragma("unroll") for (int m = 0; m < 4; ++m) _Pragma("unroll") for (int k = 0; k < 2; ++k) dst[m][k] = *(const PG8_LAS bf16x8*)(lds + PG8_SA(b, h) + aoff + m * 2048 + k * 1024); } while (0)
#define PG8_LDB(dst, b, h) do { _Pragma("unroll") for (int n = 0; n < 2; ++n) _Pragma("unroll") for (int k = 0; k < 2; ++k) dst[n][k] = *(const PG8_LAS bf16x8*)(lds + PG8_SB(b, h) + boff + n * 2048 + k * 1024); } while (0)
#define PG8_MMA(ai, bj, At, Bt) do { __builtin_amdgcn_s_setprio(1); _Pragma("unroll") for (int m = 0; m < 4; ++m) _Pragma("unroll") for (int n = 0; n < 2; ++n) _Pragma("unroll") for (int k = 0; k < 2; ++k) \
        acc[ai][bj][m][n] = __builtin_amdgcn_mfma_f32_16x16x32_bf16(Bt[n][k], At[m][k], acc[ai][bj][m][n], 0, 0, 0); __builtin_amdgcn_s_setprio(0); } while (0)
#define PG8_WAIT_V(n) asm volatile("s_waitcnt vmcnt(" #n ")" ::: "memory")
#define PG8_WAIT_L(n) asm volatile("s_waitcnt lgkmcnt(" #n ")" ::: "memory")
#define PG8_BAR __builtin_amdgcn_s_barrier()
#define PG8_SCHED __builtin_amdgcn_sched_barrier(0)
    Unit cur, nxt; int ui = 0;
    if (!S.next(0, cur)) return;
    f32x4 acc[2][2][4][2];
#pragma unroll
    for (int a = 0; a < 2; ++a)
#pragma unroll
        for (int b = 0; b < 2; ++b)
#pragma unroll
            for (int m = 0; m < 4; ++m)
#pragma unroll
                for (int n = 0; n < 2; ++n) acc[a][b][m][n] = (f32x4){0.f, 0.f, 0.f, 0.f};
    bf16x8 At[4][2], B0[2][2], B1[2][2];
    const char* cA = (const char*)g.A + (size_t)cur.pm * tstepA; const char* cB = (const char*)g.Bt + (size_t)cur.pn * tstepB;
    S.a_ready(cur);
    if constexpr (SP2) {
        PG8_STAGE(PG8_SB(0, 0), cB, voffB); PG8_STAGE(PG8_SB(0, 1), cB + hstepB, voffB); PG8_STAGE(PG8_SA(0, 0), cA, voffA); PG8_STAGE(PG8_SA(0, 1), cA + hstepA, voffA);
        if (wr == 1) PG8_BAR;
        PG8_WAIT_V(2); PG8_BAR;
        PG8_STAGE(PG8_SB(1, 0), cB + kstep, voffB); PG8_STAGE(PG8_SA(1, 0), cA + kstep, voffA); PG8_STAGE(PG8_SB(1, 1), cB + hstepB + kstep, voffB);
        PG8_WAIT_V(6); PG8_BAR;
    } else {
        PG8_STAGE(PG8_SB(0, 0), cB, voffB); PG8_STAGE(PG8_SA(0, 0), cA, voffA); PG8_STAGE(PG8_SB(0, 1), cB + hstepB, voffB); PG8_STAGE(PG8_SA(0, 1), cA + hstepA, voffA);
        if (wr == 1) PG8_BAR;
        PG8_WAIT_V(4); PG8_BAR;
        PG8_STAGE(PG8_SB(1, 0), cB + kstep, voffB); PG8_STAGE(PG8_SA(1, 0), cA + kstep, voffA); PG8_STAGE(PG8_SB(1, 1), cB + hstepB + kstep, voffB);
        PG8_WAIT_V(6); PG8_BAR;
    }
    for (;;) {
        const bool has_next = S.next(ui + 1, nxt);
        const char* nA = has_next ? (const char*)g.A + (size_t)nxt.pm * tstepA : cA; const char* nB = has_next ? (const char*)g.Bt + (size_t)nxt.pn * tstepB : cB;
        for (int t = 0; t < nt; t += 2) {
            const bool last = (t == nt - 2);
            const char* a1 = cA + (size_t)(t + 1) * kstep;
            const char* a2 = last ? nA : cA + (size_t)(t + 2) * kstep; const char* b2 = last ? nB : cB + (size_t)(t + 2) * kstep;
            const char* a3 = a2 + kstep; const char* b3 = b2 + kstep;
            if (last && has_next) S.a_ready(nxt);
            if constexpr (SP2) {
            PG8_LDB(B0, 0, 0); PG8_LDB(B1, 0, 1); PG8_SCHED; PG8_LDA(At, 0, 0); PG8_STAGE(PG8_SA(1, 1), a1 + hstepA, voffA);
            PG8_WAIT_V(8); PG8_WAIT_L(0); PG8_BAR; PG8_MMA(0, 0, At, B0); PG8_MMA(0, 1, At, B1); PG8_BAR; PG8_SCHED;
            PG8_LDA(At, 0, 1); PG8_STAGE(PG8_SB(0, 0), b2, voffB); PG8_STAGE(PG8_SB(0, 1), b2 + hstepB, voffB); PG8_STAGE(PG8_SA(0, 0), a2, voffA);
            PG8_WAIT_V(8); PG8_WAIT_L(0); PG8_BAR; PG8_MMA(1, 0, At, B0); PG8_MMA(1, 1, At, B1); PG8_BAR; PG8_SCHED;
            PG8_LDB(B0, 1, 0); PG8_LDB(B1, 1, 1); PG8_SCHED; PG8_LDA(At, 1, 0); PG8_STAGE(PG8_SA(0, 1), a2 + hstepA, voffA);
            PG8_WAIT_V(8); PG8_WAIT_L(0); PG8_BAR; PG8_MMA(0, 0, At, B0); PG8_MMA(0, 1, At, B1); PG8_BAR; PG8_SCHED;
            PG8_LDA(At, 1, 1); PG8_STAGE(PG8_SB(1, 0), b3, voffB); PG8_STAGE(PG8_SB(1, 1), b3 + hstepB, voffB); PG8_STAGE(PG8_SA(1, 0), a3, voffA);
            PG8_WAIT_V(8); PG8_WAIT_L(0); PG8_BAR; PG8_MMA(1, 0, At, B0); PG8_MMA(1, 1, At, B1); PG8_BAR; PG8_SCHED;
            } else {
            PG8_LDB(B0, 0, 0); PG8_SCHED; PG8_LDA(At, 0, 0); PG8_STAGE(PG8_SA(1, 1), a1 + hstepA, voffA);
            PG8_WAIT_L(8); PG8_BAR; PG8_WAIT_L(0); PG8_MMA(0, 0, At, B0); PG8_BAR; PG8_SCHED;
            PG8_LDB(B1, 0, 1); PG8_STAGE(PG8_SB(0, 0), b2, voffB);
            PG8_BAR; PG8_WAIT_L(0); PG8_MMA(0, 1, At, B1); PG8_BAR;
            PG8_LDA(At, 0, 1); PG8_STAGE(PG8_SA(0, 0), a2, voffA);
            PG8_BAR; PG8_WAIT_L(0); PG8_MMA(1, 0, At, B0); PG8_BAR; PG8_SCHED;
            PG8_STAGE(PG8_SB(0, 1), b2 + hstepB, voffB);
            PG8_WAIT_V(6); PG8_BAR; PG8_MMA(1, 1, At, B1); PG8_BAR;
            PG8_LDB(B0, 1, 0); PG8_SCHED; PG8_LDA(At, 1, 0); PG8_STAGE(PG8_SA(0, 1), a2 + hstepA, voffA);
            PG8_WAIT_L(8); PG8_BAR; PG8_WAIT_L(0); PG8_MMA(0, 0, At, B0); PG8_BAR; PG8_SCHED;
            PG8_LDB(B1, 1, 1); PG8_STAGE(PG8_SB(1, 0), b3, voffB);
            PG8_BAR; PG8_WAIT_L(0); PG8_MMA(0, 1, At, B1); PG8_BAR;
            PG8_LDA(At, 1, 1); PG8_STAGE(PG8_SA(1, 0), a3, voffA);
            PG8_BAR; PG8_WAIT_L(0); PG8_MMA(1, 0, At, B0); PG8_BAR; PG8_SCHED;
            PG8_STAGE(PG8_SB(1, 1), b3 + hstepB, voffB);
            PG8_WAIT_V(6); PG8_BAR; PG8_MMA(1, 1, At, B1); PG8_BAR;
            }
        }
        if constexpr (ALIGN_EPI) { if (wr == 0) PG8_BAR; }
        if constexpr (!Epi::AFTER_DRAIN) { E(acc, cur, wr, wc, fr, fq); S.done(cur); }
        if (!has_next) break;
#pragma unroll
        for (int a = 0; a < 2; ++a)
#pragma unroll
            for (int b = 0; b < 2; ++b)
#pragma unroll
                for (int m = 0; m < 4; ++m)
#pragma unroll
                    for (int n = 0; n < 2; ++n) acc[a][b][m][n] = (f32x4){0.f, 0.f, 0.f, 0.f};
        cur = nxt; cA = nA; cB = nB; ++ui;
        if constexpr (ALIGN_EPI) { if (wr == 1) PG8_BAR; }
    }
    PG8_WAIT_V(0);
    if constexpr (!ALIGN_EPI) { if (wr == 0) PG8_BAR; }
    PG8_BAR;
    if constexpr (Epi::AFTER_DRAIN) { E.fused(acc, cur, wr, wc, fr, fq, lds, wid, lane); S.done(cur); }
#undef PG8_SA
#undef PG8_SB
#undef PG8_STAGE
#undef PG8_LDA
#undef PG8_LDB
#undef PG8_MMA
#undef PG8_WAIT_V
#undef PG8_WAIT_L
#undef PG8_BAR
#undef PG8_SCHED
}
}
namespace att {
using bf16 = __hip_bfloat16;
using bf16x8 = __attribute__((ext_vector_type(8))) short;
using s16x4  = __attribute__((ext_vector_type(4))) short;
using f32x16 = __attribute__((ext_vector_type(16))) float;
using u32x4  = __attribute__((ext_vector_type(4))) unsigned;
constexpr int   D = 128, NW = 8, QBLK = 32, KVBLK = 64;
constexpr float SCALE = 0.088388347648318440f;
constexpr float ISCALE = 11.313708498984761f;
constexpr float THR = 8.f;
constexpr float NEG = -1e30f;
constexpr int TBL_FLOATS = 640;
#define KSWZ(row, colB) ((row) * 256 + ((colB) ^ (((row) & 7) << 4)))
#define SBAR() __builtin_amdgcn_sched_barrier(0)
__device__ __forceinline__ int crow(int r, int hi) { return (r & 3) + 8 * (r >> 2) + 4 * hi; }
__device__ __forceinline__ unsigned cvtpk(float lo, float hi) { unsigned r; asm volatile("v_cvt_pk_bf16_f32 %0, %1, %2" : "=v"(r) : "v"(lo), "v"(hi)); return r; }

__device__ __forceinline__ int v_rd_base(int lane) { return ((lane & 3) << 3) | (((lane >> 2) & 3) << 6) | (((lane >> 4) & 1) << 5) | (((lane >> 5) & 1) << 8); }
template <int OFF> __device__ __forceinline__ s16x4 tr_read(int vb) {
  s16x4 r; asm volatile("ds_read_b64_tr_b16 %0, %1 offset:%2" : "=&v"(r) : "v"(vb), "i"(OFF) : "memory"); return r;
}
constexpr int v_rd_off2(int ncb, int d0, int ks, int half) { return d0 * 512 + ks * (ncb * 1024) + half * (ncb * 512); }
template <int NCB> struct DmaGeo { static constexpr int KB = 16384, VB = 64 * NCB * 64, BUF = KB + VB, SCR = 2 * BUF, LDS_BYTES = SCR + NW * 256; };
constexpr int A_LDS_BYTES = DmaGeo<8>::LDS_BYTES, TBL2_OFF = DmaGeo<4>::LDS_BYTES;
template <int H> __device__ __forceinline__ void qk_half(f32x16& p, const char* Ks, const bf16x8* qr, int r32, int hi) {
  p = f32x16{};
#pragma unroll
  for (int d0 = 0; d0 < 8; ++d0) { const int cb = (d0 * 16 + hi * 8) * 2;
    const bf16x8 b = *reinterpret_cast<const bf16x8*>(Ks + KSWZ(32 * H + r32, cb));
    p = __builtin_amdgcn_mfma_f32_32x32x16_bf16(b, qr[d0], p, 0, 0, 0); }
}
__device__ __forceinline__ void sm_half(f32x16& p, float& m_reg, float& l_reg, float& alpha, bf16x8& paA, bf16x8& paB) {
  constexpr float C = SCALE * 1.4426950408889634f;
  float pmax = p[0];
#pragma unroll
  for (int r = 1; r < 16; ++r) pmax = fmaxf(pmax, p[r]);
  { auto rr = __builtin_amdgcn_permlane32_swap(__float_as_uint(pmax), __float_as_uint(pmax), false, false);
    pmax = fmaxf(__uint_as_float(rr[0]), __uint_as_float(rr[1])); }
  float mn;
  if (__builtin_expect(__all(pmax - m_reg <= THR / SCALE), 1)) { mn = m_reg; alpha = 1.f; }
  else { mn = fmaxf(m_reg, pmax); alpha = __builtin_amdgcn_exp2f((m_reg - mn) * C); m_reg = mn; }
  const float mnC = -mn * C;
#pragma unroll
  for (int r = 0; r < 16; ++r) p[r] = __builtin_amdgcn_exp2f(fmaf(p[r], C, mnC));
  float ps = 0;
#pragma unroll
  for (int r = 0; r < 16; ++r) ps += p[r];
  { auto rr = __builtin_amdgcn_permlane32_swap(__float_as_uint(ps), __float_as_uint(ps), false, false);
    ps = __uint_as_float(rr[0]) + __uint_as_float(rr[1]); }
  l_reg = l_reg * alpha + ps;
#define PK4(P, BASE, OUT) do { unsigned a0 = cvtpk(P[BASE + 0], P[BASE + 1]), a1 = cvtpk(P[BASE + 2], P[BASE + 3]);   \
    unsigned b0 = cvtpk(P[BASE + 4], P[BASE + 5]), b1 = cvtpk(P[BASE + 6], P[BASE + 7]);                              \
    auto r0 = __builtin_amdgcn_permlane32_swap(a0, b0, false, false); auto r1 = __builtin_amdgcn_permlane32_swap(a1, b1, false, false); \
    u32x4 w = {r0[0], r1[0], r0[1], r1[1]}; OUT = *reinterpret_cast<bf16x8*>(&w); } while (0)
  PK4(p, 0, paA); PK4(p, 8, paB);
#undef PK4
}
template <int NCB, int D0, int KS0> __device__ __forceinline__ void pv_pair(f32x16& oa, f32x16& ob, int vb, bf16x8 paA, bf16x8 paB) {
  const s16x4 al0 = tr_read<v_rd_off2(NCB, D0, KS0, 0)>(vb), ah0 = tr_read<v_rd_off2(NCB, D0, KS0, 1)>(vb), al1 = tr_read<v_rd_off2(NCB, D0, KS0 + 1, 0)>(vb), ah1 = tr_read<v_rd_off2(NCB, D0, KS0 + 1, 1)>(vb);
  const s16x4 bl0 = tr_read<v_rd_off2(NCB, D0 + 1, KS0, 0)>(vb), bh0 = tr_read<v_rd_off2(NCB, D0 + 1, KS0, 1)>(vb), bl1 = tr_read<v_rd_off2(NCB, D0 + 1, KS0 + 1, 0)>(vb), bh1 = tr_read<v_rd_off2(NCB, D0 + 1, KS0 + 1, 1)>(vb);
  asm volatile("s_waitcnt lgkmcnt(0)" ::: "memory"); SBAR();
#define PK(L, H) (bf16x8){L[0], L[1], L[2], L[3], H[0], H[1], H[2], H[3]}
  oa = __builtin_amdgcn_mfma_f32_32x32x16_bf16(PK(al0, ah0), paA, oa, 0, 0, 0);
  ob = __builtin_amdgcn_mfma_f32_32x32x16_bf16(PK(bl0, bh0), paA, ob, 0, 0, 0);
  oa = __builtin_amdgcn_mfma_f32_32x32x16_bf16(PK(al1, ah1), paB, oa, 0, 0, 0);
  ob = __builtin_amdgcn_mfma_f32_32x32x16_bf16(PK(bl1, bh1), paB, ob, 0, 0, 0);
#undef PK
}
template <int NCB, int KS0> __device__ __forceinline__ void pv_half(f32x16* o, int vb, bf16x8 paA, bf16x8 paB) {
  pv_pair<NCB, 0, KS0>(o[0], o[1], vb, paA, paB); pv_pair<NCB, 2, KS0>(o[2], o[3], vb, paA, paB);
  if constexpr (NCB == 8) { pv_pair<NCB, 4, KS0>(o[4], o[5], vb, paA, paB); pv_pair<NCB, 6, KS0>(o[6], o[7], vb, paA, paB); }
}
struct ModA2 {
  float slopeS; int qk0;
  template <int H> __device__ __forceinline__ bool skip(int) const { return false; }
  __device__ __forceinline__ float m_init() const { return -1e30f; }
  __device__ __forceinline__ float l_init() const { return 0.f; }
  template <int H> __device__ __forceinline__ void apply(f32x16& p, int jt) const {
    const float d0 = (float)(qk0 - jt * KVBLK - 32 * H), ns = -slopeS;
#pragma unroll
    for (int r = 0; r < 16; ++r) { const float c = (float)((r & 3) + 8 * (r >> 2)); p[r] = fmaf(ns, fabsf(d0 - c), p[r]); }
  }
};
struct ModC2 {
  float slopeS, sinkS; int qk0; int qw0;
  template <int H> __device__ __forceinline__ bool skip(int jt) const { const int d = qw0 - jt * KVBLK - 32 * H; return d > 128 + 31 || d < -(128 + 31); }
  __device__ __forceinline__ float m_init() const { return sinkS; }
  __device__ __forceinline__ float l_init() const { return 1.f; }
  template <int H> __device__ __forceinline__ void apply(f32x16& p, int jt) const {
    const float d0 = (float)(qk0 - jt * KVBLK - 32 * H), ns = -slopeS;
#pragma unroll
    for (int r = 0; r < 16; ++r) { const float c = (float)((r & 3) + 8 * (r >> 2)); const float e = fabsf(d0 - c); p[r] = e <= 128.f ? fmaf(ns, e, p[r]) : NEG; }
  }
};
struct ModB2 {
  const float* tbl;
  int r, r_start, kr0, tb0, kc0;
  int rs_u, cw0;
  template <int H> __device__ __forceinline__ bool skip(int jt) const { const int kr = kr0 + jt; if ((unsigned)(kr - rs_u) >= 8u) return true;
    const int lo = cw0 - 8 < 0 ? 0 : cw0 - 8, hi_ = (cw0 + 23 > 48 ? 48 : cw0 + 23) + 15; return 32 * H > hi_ || 32 * H + 31 < lo; }
  __device__ __forceinline__ float m_init() const { return -1e5f; }
  __device__ __forceinline__ float l_init() const { return 0.f; }
  template <int H> __device__ __forceinline__ void apply(f32x16& p, int jt) const {
    const int kr = kr0 + jt; const bool rowok = (unsigned)(kr - r_start) < 8u;
    int drow = kr - r + 7; drow = drow < 0 ? 0 : (drow > 14 ? 14 : drow);
    const float* tb = tbl + (tb0 + drow * 31 + 32 * H);
#pragma unroll
    for (int rr = 0; rr < 16; ++rr) { const int c = (rr & 3) + 8 * (rr >> 2);
      const bool ok = rowok && (unsigned)(c + 32 * H + kc0) < 16u; const float b = tb[c];
      p[rr] = ok ? p[rr] + b : NEG; }
  }
};
template <int NCB, int LDQ, int LDK, int LDO, class Mod>
__device__ __forceinline__ void attn_unit_dma(const bf16* __restrict__ Qb, const bf16* __restrict__ Kh, const bf16* __restrict__ Vh, bf16* __restrict__ Ob, int NT, const Mod& mod,
                                              __attribute__((address_space(3))) unsigned char* ldsl) {
  typedef __attribute__((address_space(3))) unsigned LU; typedef DmaGeo<NCB> G;
  const int tid = tid_fresh(), wid = __builtin_amdgcn_readfirstlane(tid >> 6), lane = tid & 63, r32 = lane & 31, hi = lane >> 5;
  char* lds = (char*)ldsl;
  float m_reg = mod.m_init(), l_reg = mod.l_init(); f32x16 o[NCB] = {}; bf16x8 qr[8];
  const bf16* Qw = Qb + (long)(wid * QBLK + r32) * LDQ + hi * 8;
#pragma unroll
  for (int d0 = 0; d0 < 8; ++d0) qr[d0] = *reinterpret_cast<const bf16x8*>(Qw + d0 * 16);
  const int krow = 4 * wid + (lane >> 4);
  const unsigned koff = (unsigned)(krow * LDK + (((lane & 15) ^ (krow & 7)) * 8)) * 2u;
  constexpr int PPK = NCB / 2, KSTEP = 64 / PPK;
  const int kk0 = (wid / PPK) * 8 + ((lane & 31) >> 2), vk0 = (kk0 & ~0xC) | ((kk0 & 4) << 1) | ((kk0 & 8) >> 1);
  const unsigned voff = (unsigned)(vk0 * LDK + ((2 * (wid % PPK) + (lane >> 5)) * 32 + (lane & 3) * 8)) * 2u;
  constexpr size_t TILE_B = (size_t)KVBLK * LDK * 2;
#define DMA_TILE(b, jt) do { const char* kg_ = (const char*)Kh + (size_t)(jt) * TILE_B; const char* vg_ = (const char*)Vh + (size_t)(jt) * TILE_B;                              \
    __builtin_amdgcn_global_load_lds((const unsigned*)(kg_ + koff), (LU*)(ldsl + (b) * G::BUF + wid * 1024), 16, 0, 0);                                                       \
    __builtin_amdgcn_global_load_lds((const unsigned*)(kg_ + koff + 32 * LDK * 2), (LU*)(ldsl + (b) * G::BUF + (wid + 8) * 1024), 16, 0, 0);                                  \
    _Pragma("unroll") for (int i_ = 0; i_ < PPK; ++i_)                                                                                                                        \
      __builtin_amdgcn_global_load_lds((const unsigned*)(vg_ + voff + i_ * KSTEP * LDK * 2), (LU*)(ldsl + (b) * G::BUF + G::KB + (wid + 8 * i_) * 1024), 16, 0, 0); } while (0)
#define TILE_SYNC() do { asm volatile("s_waitcnt vmcnt(0)" ::: "memory"); __syncthreads(); } while (0)
#define RESC(a) do { if (__any((a) < 1.f)) { asm volatile("; rescale (rare): keep this a real branch" ::: "memory"); \
    _Pragma("unroll") for (int d = 0; d < NCB; ++d) _Pragma("unroll") for (int r = 0; r < 16; ++r) o[d][r] *= (a); } } while (0)
  const int vbase = (int)(uintptr_t)(ldsl + G::KB) + v_rd_base(lane);
  DMA_TILE(0, 0); TILE_SYNC();
  for (int j = 0; j < NT; ++j) {
    const int b = j & 1;
    if (j + 1 < NT) DMA_TILE(b ^ 1, j + 1);
    const char* Ks = lds + b * G::BUF; const int vb = vbase + b * G::BUF;
    f32x16 p0, p1; float alpha; bf16x8 paA, paB;
    if (!mod.template skip<0>(j)) { qk_half<0>(p0, Ks, qr, r32, hi); mod.template apply<0>(p0, j); sm_half(p0, m_reg, l_reg, alpha, paA, paB); RESC(alpha); SBAR(); pv_half<NCB, 0>(o, vb, paA, paB); }
    if (!mod.template skip<1>(j)) { qk_half<1>(p1, Ks, qr, r32, hi); mod.template apply<1>(p1, j); sm_half(p1, m_reg, l_reg, alpha, paA, paB); RESC(alpha); SBAR(); pv_half<NCB, 2>(o, vb, paA, paB); }
    TILE_SYNC();
  }
  const float rl = __builtin_amdgcn_rcpf(l_reg);
  unsigned short* Orow = (unsigned short*)Ob + (long)(wid * QBLK + r32) * LDO + hi * 8;
#pragma unroll
  for (int d0 = 0; d0 < NCB; ++d0)
#pragma unroll
    for (int g = 0; g < 4; g += 2) {
      unsigned ax = cvtpk(o[d0][4 * g + 0] * rl, o[d0][4 * g + 1] * rl), ay = cvtpk(o[d0][4 * g + 2] * rl, o[d0][4 * g + 3] * rl);
      unsigned bx = cvtpk(o[d0][4 * g + 4] * rl, o[d0][4 * g + 5] * rl), by = cvtpk(o[d0][4 * g + 6] * rl, o[d0][4 * g + 7] * rl);
      auto rx = __builtin_amdgcn_permlane32_swap(ax, bx, false, false); auto ry = __builtin_amdgcn_permlane32_swap(ay, by, false, false);
      u32x4 w = {rx[0], ry[0], rx[1], ry[1]};
      *reinterpret_cast<u32x4*>(Orow + d0 * 32 + 8 * g) = w; }
#undef DMA_TILE
#undef TILE_SYNC
#undef RESC
}
template <int LDQ, int LDK, int LDO, class Mod>
__device__ __forceinline__ void attn_unit_dma_A(const bf16* __restrict__ Qb, const bf16* __restrict__ Kh, const bf16* __restrict__ Vh, bf16* __restrict__ Ob, int q0, int seq_tiles, float slope, float needC, const Mod& mod,
                                              __attribute__((address_space(3))) unsigned char* ldsl, volatile __attribute__((address_space(3))) float* red) {
  constexpr int NCB = 8;
  typedef __attribute__((address_space(3))) unsigned LU; typedef DmaGeo<NCB> G;
  const int tid = tid_fresh(), wid = __builtin_amdgcn_readfirstlane(tid >> 6), lane = tid & 63, r32 = lane & 31, hi = lane >> 5;
  char* lds = (char*)ldsl;
  float m_reg = mod.m_init(), l_reg = mod.l_init(); f32x16 o[NCB] = {}; bf16x8 qr[8];
  const bf16* Qw = Qb + (long)(wid * QBLK + r32) * LDQ + hi * 8;
#pragma unroll
  for (int d0 = 0; d0 < 8; ++d0) qr[d0] = *reinterpret_cast<const bf16x8*>(Qw + d0 * 16);
  const int krow = 4 * wid + (lane >> 4);
  const unsigned koff = (unsigned)(krow * LDK + (((lane & 15) ^ (krow & 7)) * 8)) * 2u;
  constexpr int PPK = NCB / 2, KSTEP = 64 / PPK;
  const int kk0 = (wid / PPK) * 8 + ((lane & 31) >> 2), vk0 = (kk0 & ~0xC) | ((kk0 & 4) << 1) | ((kk0 & 8) >> 1);
  const unsigned voff = (unsigned)(vk0 * LDK + ((2 * (wid % PPK) + (lane >> 5)) * 32 + (lane & 3) * 8)) * 2u;
  constexpr size_t TILE_B = (size_t)KVBLK * LDK * 2;
#define DMA_TILE(b, jt) do { const char* kg_ = (const char*)Kh + (size_t)(jt) * TILE_B; const char* vg_ = (const char*)Vh + (size_t)(jt) * TILE_B;                              \
    __builtin_amdgcn_global_load_lds((const unsigned*)(kg_ + koff), (LU*)(ldsl + (b) * G::BUF + wid * 1024), 16, 0, 0);                                                       \
    __builtin_amdgcn_global_load_lds((const unsigned*)(kg_ + koff + 32 * LDK * 2), (LU*)(ldsl + (b) * G::BUF + (wid + 8) * 1024), 16, 0, 0);                                  \
    _Pragma("unroll") for (int i_ = 0; i_ < PPK; ++i_)                                                                                                                        \
      __builtin_amdgcn_global_load_lds((const unsigned*)(vg_ + voff + i_ * KSTEP * LDK * 2), (LU*)(ldsl + (b) * G::BUF + G::KB + (wid + 8 * i_) * 1024), 16, 0, 0); } while (0)
#define TILE_SYNC() do { asm volatile("s_waitcnt vmcnt(0)" ::: "memory"); __syncthreads(); } while (0)
#define RESC(a) do { if (__any((a) < 1.f)) { asm volatile("; rescale (rare): keep this a real branch" ::: "memory"); \
    _Pragma("unroll") for (int d = 0; d < NCB; ++d) _Pragma("unroll") for (int r = 0; r < 16; ++r) o[d][r] *= (a); } } while (0)
  const int vbase = (int)(uintptr_t)(ldsl + G::KB) + v_rd_base(lane);
  const int tq = q0 >> 6;
  int c0 = tq - 1; c0 = c0 < 0 ? 0 : c0; int c1 = tq + 5; c1 = c1 > seq_tiles ? seq_tiles : c1;
  int L0 = 0, nL = 0, n = c1 - c0;
#define JT_(j) (seg == 0 ? c0 + (j) : ((j) < nL ? L0 + (j) : c1 + (j) - nL))
  for (int seg = 0; seg < 2; ++seg) {
    if (n > 0) {
      DMA_TILE(0, JT_(0)); TILE_SYNC();
      for (int j = 0; j < n; ++j) {
        const int b = j & 1;
        if (j + 1 < n) DMA_TILE(b ^ 1, JT_(j + 1));
        const int jt = JT_(j);
        const char* Ks = lds + b * G::BUF; const int vb = vbase + b * G::BUF;
        f32x16 p0, p1; float alpha; bf16x8 paA, paB;
        { qk_half<0>(p0, Ks, qr, r32, hi); mod.template apply<0>(p0, jt); sm_half(p0, m_reg, l_reg, alpha, paA, paB); RESC(alpha); SBAR(); pv_half<NCB, 0>(o, vb, paA, paB); }
        { qk_half<1>(p1, Ks, qr, r32, hi); mod.template apply<1>(p1, jt); sm_half(p1, m_reg, l_reg, alpha, paA, paB); RESC(alpha); SBAR(); pv_half<NCB, 2>(o, vb, paA, paB); }
        TILE_SYNC();
      }
    }
    if (seg == 0) {
      float lse = fmaf(m_reg, SCALE, __logf(l_reg));
#pragma unroll
      for (int o_ = 1; o_ < 64; o_ <<= 1) lse = fminf(lse, __shfl_xor(lse, o_));
      if (lane == 0) red[wid] = lse;
      __syncthreads();
      float lmin = red[0];
#pragma unroll
      for (int w_ = 1; w_ < 8; ++w_) lmin = fminf(lmin, red[w_]);
      __syncthreads();
      float d0f = (needC - lmin) / slope + 1.f; d0f = d0f < 0.f ? 0.f : d0f; const float smax = (float)(seq_tiles * 64);
      const int d0 = __builtin_amdgcn_readfirstlane(d0f > smax ? seq_tiles * 64 : (int)d0f);
      int klo = q0 - d0; klo = klo < 0 ? 0 : (klo >> 6);
      int khi = q0 + 256 + d0; khi = khi > seq_tiles * 64 ? seq_tiles : ((khi + 63) >> 6);
      L0 = klo; nL = c0 - klo; nL = nL < 0 ? 0 : nL;
      int nR = khi - c1; nR = nR < 0 ? 0 : nR;
      n = nL + nR;
    }
  }
#undef JT_
  const float rl = __builtin_amdgcn_rcpf(l_reg);
  unsigned short* Orow = (unsigned short*)Ob + (long)(wid * QBLK + r32) * LDO + hi * 8;
#pragma unroll
  for (int d0 = 0; d0 < NCB; ++d0)
#pragma unroll
    for (int g = 0; g < 4; g += 2) {
      unsigned ax = cvtpk(o[d0][4 * g + 0] * rl, o[d0][4 * g + 1] * rl), ay = cvtpk(o[d0][4 * g + 2] * rl, o[d0][4 * g + 3] * rl);
      unsigned bx = cvtpk(o[d0][4 * g + 4] * rl, o[d0][4 * g + 5] * rl), by = cvtpk(o[d0][4 * g + 6] * rl, o[d0][4 * g + 7] * rl);
      auto rx = __builtin_amdgcn_permlane32_swap(ax, bx, false, false); auto ry = __builtin_amdgcn_permlane32_swap(ay, by, false, false);
      u32x4 w = {rx[0], ry[0], rx[1], ry[1]};
      *reinterpret_cast<u32x4*>(Orow + d0 * 32 + 8 * g) = w; }
#undef DMA_TILE
#undef TILE_SYNC
#undef RESC
}
}
constexpr int NWAVES = 8;
constexpr int BATCH = 2, SEQ = 8192, DM = 2048, DFF = 5632, DEPTH = 4, HD = 128;
constexpr int M = BATCH * SEQ;
constexpr int LD2 = DM + 128, LDF = DFF + 128;
constexpr int LDQA = 6144 + 128, LDQC = 3072 + 128, LDOC = 4096 + 128;
constexpr int NGU = 2 * DFF;
constexpr float RMS_EPS = 1e-6f;
constexpr size_t MiB = 1u << 20;
constexpr size_t WS_CTL = 0, CTL_ZERO_BYTES = 1 * MiB;
constexpr size_t SZ_WGU = (size_t)NGU * LD2 * 2, SZ_WDN = (size_t)DM * LDF * 2, SZ_WQKV = (size_t)6144 * LD2 * 2, SZ_WO = (size_t)DM * LD2 * 2;
constexpr size_t WS_WGU = 2 * MiB;
constexpr size_t WS_WDN = WS_WGU + 8 * SZ_WGU;
constexpr size_t WS_WQKV = WS_WDN + 8 * SZ_WDN;
constexpr size_t WS_WO = WS_WQKV + 4 * SZ_WQKV;
constexpr size_t WS_H = WS_WO + 4 * SZ_WO;
constexpr size_t WS_ACT = WS_H + (size_t)M * LD2 * 2;
constexpr size_t WS_QKV = WS_ACT + (size_t)M * LDF * 2;
constexpr size_t WS_OC = WS_QKV + (size_t)M * LDQA * 2;
constexpr size_t WS_O = WS_OC + (size_t)M * LDOC * 2;
constexpr size_t WS_ROWSS = WS_O + (size_t)M * LD2 * 2;
constexpr size_t WS_END = WS_ROWSS + (size_t)12 * M * 32 * 4;
constexpr int CW_Q = 8192;
constexpr int CW_BAR = 4096;
constexpr int RING_OFF = 0, RING_BYTES = 131072;
constexpr int LDSCTL_OFF = RING_BYTES, MISC_OFF = LDSCTL_OFF + 320;
constexpr int RSTD_OFF = LDSCTL_OFF + 2048;
constexpr int QKN_OFF = LDSCTL_OFF + 4096;
constexpr int LDS_BYTES = 147456;
static_assert(att::A_LDS_BYTES <= RING_BYTES && att::TBL2_OFF + att::TBL_FLOATS * 4 <= RING_BYTES, "attention LDS inside the ring region");

#define GAS __attribute__((address_space(1)))
#define LAS __attribute__((address_space(3)))
typedef unsigned short bf16;
typedef unsigned v4u __attribute__((ext_vector_type(4)));
typedef unsigned v2u __attribute__((ext_vector_type(2)));
typedef float f32x4 __attribute__((ext_vector_type(4)));
typedef short bf16x8 __attribute__((ext_vector_type(8)));
#define LDS_WAIT() asm volatile("s_waitcnt lgkmcnt(0)" ::: "memory")
#define VM_WAIT() asm volatile("s_waitcnt vmcnt(0)" ::: "memory")
__device__ __forceinline__ unsigned pk2(float lo, float hi) { return pg8::cvt_pk_bf16(lo, hi); }
__device__ __forceinline__ float bflo(unsigned w) { return __uint_as_float(w << 16); }
__device__ __forceinline__ float bfhi(unsigned w) { return __uint_as_float(w & 0xffff0000u); }

#define XB_TMO      128
#define XB_XCNT(j)  (256  + 64 * (j))
#define XB_XSUB(j)  (1280 + 64 * (j))
#define XB_XGEN(j)  (2304 + 64 * (j))
#define XB_TOP      3328
#define XB_TOPGEN   3392
#define XCD_BAR_WORDS 3456
#define XB_SPIN_CAP (1u << 23)

__device__ __forceinline__ unsigned xb_ld(unsigned* p)              { return __hip_atomic_load(p, __ATOMIC_RELAXED, __HIP_MEMORY_SCOPE_AGENT); }
__device__ __forceinline__ unsigned xb_add(unsigned* p, unsigned v) { return __hip_atomic_fetch_add(p, v, __ATOMIC_RELAXED, __HIP_MEMORY_SCOPE_AGENT); }
__device__ __forceinline__ unsigned xb_xcc_id() { return (unsigned)__builtin_amdgcn_s_getreg((3 << 11) | 20) & 0xFu; }
#define XB_SPIN(cond, bar) do { unsigned _sp = 0; while (cond) { __builtin_amdgcn_s_sleep(1); \
    if ((++_sp & 255u) == 0u) { if (xb_ld(&(bar)[XB_TMO])) break; if (_sp > XB_SPIN_CAP) { atomicAdd(&(bar)[XB_TMO], 1u); break; } } } } while (0)

struct XcdBarrier {
    unsigned* bar; unsigned x;
    volatile LAS unsigned* st;
};

__device__ __forceinline__ XcdBarrier xcd_barrier_post(unsigned* bar, volatile LAS unsigned* st) {
    XcdBarrier b; b.bar = bar; b.x = xb_xcc_id(); b.st = st;
    if (threadIdx.x == 0) (void)xb_add(&bar[XB_XCNT(b.x)], 1u);
    return b;
}
__device__ __forceinline__ void xcd_barrier_complete(unsigned* bar, unsigned x, unsigned& nloc, unsigned& nx) {
    const unsigned G = gridDim.x * gridDim.y * gridDim.z;
    unsigned sum, cnt, mine, sp = 0u;
    for (;;) {
        sum = 0u; cnt = 0u; mine = 0u;
#pragma unroll
        for (unsigned j = 0; j < 16; ++j) { const unsigned c = xb_ld(&bar[XB_XCNT(j)]); sum += c; cnt += (c > 0u) ? 1u : 0u; mine = (j == x) ? c : mine; }
        if (sum == G) break;
        __builtin_amdgcn_s_sleep(1);
        if ((++sp & 255u) == 0u) { if (xb_ld(&bar[XB_TMO])) break; if (sp > XB_SPIN_CAP) { atomicAdd(&bar[XB_TMO], 1u); break; } }
    }
    nloc = mine > 0u ? mine : 1u; nx = cnt > 0u ? cnt : 1u;
}

__device__ __forceinline__ void xcd_barrier(const XcdBarrier& b) {
    asm volatile("s_waitcnt vmcnt(0)" ::: "memory");
    __syncthreads();
    if (threadIdx.x == 0) {
        unsigned* bar = b.bar;
        __builtin_amdgcn_s_waitcnt(0);
        unsigned nloc = b.st[0], nx = b.st[1];
        if (nloc == 0u) { xcd_barrier_complete(bar, b.x, nloc, nx); b.st[0] = nloc; b.st[1] = nx; }
        const unsigned old = xb_add(&bar[XB_XSUB(b.x)], 1u);
        const unsigned gen = old / nloc;
        if (old + 1u == (gen + 1u) * nloc) {
            __builtin_amdgcn_fence(__ATOMIC_RELEASE, "agent");
            asm volatile("s_waitcnt vmcnt(0)" ::: "memory");
            const unsigned og = xb_add(&bar[XB_TOP], 1u);
            const unsigned tg = og / nx;
            if (og + 1u == (tg + 1u) * nx) xb_add(&bar[XB_TOPGEN], 1u);
            else XB_SPIN(xb_ld(&bar[XB_TOPGEN]) == tg, bar);
            __builtin_amdgcn_fence(__ATOMIC_ACQUIRE, "agent");
            xb_add(&bar[XB_XGEN(b.x)], 1u);
            asm volatile("s_waitcnt vmcnt(0)" ::: "memory");
        } else {
            XB_SPIN(xb_ld(&bar[XB_XGEN(b.x)]) == gen, bar);
            __builtin_amdgcn_fence(__ATOMIC_ACQUIRE, "agent");
            asm volatile("s_waitcnt vmcnt(0)" ::: "memory");
        }
    }
    __syncthreads();
}

constexpr int PTR_OFF = LDSCTL_OFF + 1024;
constexpr int I_OUT = 29, I_WS = 30, N_PTRS = 31;
__device__ __forceinline__ unsigned long long tbl_u64(LAS unsigned char* lds, int i) {
    const unsigned long long v = ((volatile LAS unsigned long long*)(lds + PTR_OFF))[i];
    const unsigned lo = __builtin_amdgcn_readfirstlane((unsigned)v), hi = __builtin_amdgcn_readfirstlane((unsigned)(v >> 32));
    return ((unsigned long long)hi << 32) | lo;
}
__device__ __forceinline__ const float* tbl_in(LAS unsigned char* lds, int i) { return (const float*)(const GAS float*)tbl_u64(lds, i); }
__device__ __forceinline__ unsigned char* tbl_ws(LAS unsigned char* lds) { return (unsigned char*)(GAS unsigned char*)tbl_u64(lds, I_WS); }
struct Geo { int tid, lane, wave, vcu, G, gw, NGW; };
__device__ __forceinline__ Geo geo() { Geo g; g.tid = tid_fresh(); g.lane = g.tid & 63; g.wave = __builtin_amdgcn_readfirstlane(g.tid >> 6);
    g.G = gridDim.x; { const int bx = blockIdx.x; g.vcu = (g.G % 8 == 0) ? (bx % 8) * (g.G / 8) + bx / 8 : bx; } g.gw = g.vcu * NWAVES + g.wave; g.NGW = g.G * NWAVES; return g; }
__device__ __forceinline__ float wave_sum(float v) {
#pragma unroll
    for (int o = 1; o < 64; o <<= 1) v += __shfl_xor(v, o);
    return v;
}
__device__ __forceinline__ void p0_transpose_item(const float* W, const float* g, int K, int N, bf16* WT, int k0, int n0, int drow0, LAS float* scr, int lane) {
    const int ldw = K + 128;
    const int c = lane & 7;
    f32x4 ga = (f32x4){1.f, 1.f, 1.f, 1.f}, gb = ga;
    if (g) { ga = *(const GAS f32x4*)(g + k0 + 8 * c); gb = *(const GAS f32x4*)(g + k0 + 8 * c + 4); }
#pragma unroll 8
    for (int i = 0; i < 32; ++i) { const int kk = 2 * i + (lane >> 5); scr[kk * 33 + (lane & 31)] = __builtin_nontemporal_load(&W[(size_t)(k0 + kk) * N + n0 + (lane & 31)]); }
    LDS_WAIT(); asm volatile("" ::: "memory");
#pragma unroll
    for (int j = 0; j < 4; ++j) { const int n = (lane >> 3) + 8 * j; const LAS float* s = scr + (8 * c) * 33 + n;
        v4u o; o.x = pk2(s[0 * 33] * ga.x, s[1 * 33] * ga.y); o.y = pk2(s[2 * 33] * ga.z, s[3 * 33] * ga.w); o.z = pk2(s[4 * 33] * gb.x, s[5 * 33] * gb.y); o.w = pk2(s[6 * 33] * gb.z, s[7 * 33] * gb.w);
        *(GAS v4u*)(WT + (size_t)(drow0 + n) * ldw + k0 + 8 * c) = o; }
    LDS_WAIT(); asm volatile("" ::: "memory");
}
__device__ __forceinline__ void p0_plain(const float* W, const float* g, int K, int N, bf16* WT, int item, LAS float* scr, int lane) {
    const int nblk = N / 32, kb = item / nblk, nb = item % nblk;
    p0_transpose_item(W, g, K, N, WT, 64 * kb, 32 * nb, 32 * nb, scr, lane);
}
__device__ __forceinline__ void p0_gu(const float* W, const float* g, bf16* WT, int up, int item, LAS float* scr, int lane) {
    const int nblk = DFF / 32, kb = item / nblk, nb = item % nblk, n0 = 32 * nb;
    p0_transpose_item(W, g, DM, DFF, WT, 64 * kb, n0, (n0 >> 7) * 256 + up * 128 + (n0 & 127), scr, lane);
}

__device__ __forceinline__ void xcast_phase(const float* x, bf16* xb, float* rowss) {
    const Geo F = geo(); const int gw = F.gw, NGW = F.NGW;
    for (int m = gw; m < M; m += NGW) {
        const GAS f32x4* xr = (const GAS f32x4*)(x + (size_t)m * DM) + F.lane;
        f32x4 v[8]; float s = 0.f;
#pragma unroll
        for (int j = 0; j < 8; ++j) v[j] = xr[64 * j];
        GAS v2u* o8 = (GAS v2u*)(xb + (size_t)m * LD2) + F.lane;
#pragma unroll
        for (int j = 0; j < 8; ++j) { v2u w; w.x = pk2(v[j].x, v[j].y); w.y = pk2(v[j].z, v[j].w); o8[64 * j] = w;
            const float r0 = bflo(w.x), r1 = bfhi(w.x), r2 = bflo(w.y), r3 = bfhi(w.y); s += (r0 * r0 + r1 * r1) + (r2 * r2 + r3 * r3); }
        s = wave_sum(s);
        if (F.lane < 32) rowss[(size_t)m * 32 + F.lane] = F.lane == 0 ? s : 0.f;
    }
}
__device__ __forceinline__ void combineA_phase(const bf16* OC, bf16* O, float lam, float post, const float* sg) {
    const Geo F = geo(); const int gw = F.gw, NGW = F.NGW;
    const int half = F.lane >> 5, li = F.lane & 31;
    const f32x4 s0 = *((const GAS f32x4*)sg + 2 * li), s1 = *((const GAS f32x4*)sg + 2 * li + 1);
    for (int t = gw; t < M * 4; t += NGW) {
        const int task = t * 2 + half, row = task >> 3, h = task & 7;
        const v4u a = *(const GAS v4u*)(OC + (size_t)row * LDOC + (h * 2 + 0) * 256 + li * 8);
        const v4u b = *(const GAS v4u*)(OC + (size_t)row * LDOC + (h * 2 + 1) * 256 + li * 8);
        float d[8] = {bflo(a.x) - lam * bflo(b.x), bfhi(a.x) - lam * bfhi(b.x), bflo(a.y) - lam * bflo(b.y), bfhi(a.y) - lam * bfhi(b.y),
                      bflo(a.z) - lam * bflo(b.z), bfhi(a.z) - lam * bfhi(b.z), bflo(a.w) - lam * bflo(b.w), bfhi(a.w) - lam * bfhi(b.w)};
        float s = 0.f;
#pragma unroll
        for (int i = 0; i < 8; ++i) s += d[i] * d[i];
        s += __shfl_xor(s, 1); s += __shfl_xor(s, 2); s += __shfl_xor(s, 4); s += __shfl_xor(s, 8); s += __shfl_xor(s, 16);
        const float rs = post / sqrtf(s * (1.f / 256.f) + RMS_EPS);
        v4u o; o.x = pk2(d[0] * rs * s0.x, d[1] * rs * s0.y); o.y = pk2(d[2] * rs * s0.z, d[3] * rs * s0.w);
        o.z = pk2(d[4] * rs * s1.x, d[5] * rs * s1.y); o.w = pk2(d[6] * rs * s1.z, d[7] * rs * s1.w);
        *(GAS v4u*)(O + (size_t)row * LD2 + h * 256 + li * 8) = o;
    }
}

__device__ __forceinline__ int clampi(int v, int lo, int hi) { return v < lo ? lo : (v > hi ? hi : v); }
__device__ __forceinline__ void attnA_phase(const bf16* QKV, bf16* OC, const float* gq, const float* gk, unsigned* qctr, LAS unsigned char* ldsl) {
    const Geo F = geo();
    volatile LAS unsigned* slot = (volatile LAS unsigned*)(ldsl + MISC_OFF) + 16;
    float gmq = fmaxf(fabsf(gq[F.lane]), fabsf(gq[F.lane + 64])), gmk = fmaxf(fabsf(gk[F.lane]), fabsf(gk[F.lane + 64]));
#pragma unroll
    for (int o = 1; o < 64; o <<= 1) { gmq = fmaxf(gmq, __shfl_xor(gmq, o)); gmk = fmaxf(gmk, __shfl_xor(gmk, o)); }
    const float twoB = 2.f * gmq * gmk * att::ISCALE;
    const int qi = blockIdx.x & 7;
    unsigned* ctr = qctr + 64 * qi;
    unsigned* gctr = qctr + 8 * 64;
    bool own = true;
    for (;;) {
        if (F.tid == 0) {
            unsigned v = own ? __hip_atomic_fetch_add(ctr, 1u, __ATOMIC_RELAXED, __HIP_MEMORY_SCOPE_AGENT) : 64u;
            if (v >= 64u) v = 64u + __hip_atomic_fetch_add(gctr, 1u, __ATOMIC_RELAXED, __HIP_MEMORY_SCOPE_AGENT);
            slot[0] = v; }
        __syncthreads();
        const unsigned p = (unsigned)__builtin_amdgcn_readfirstlane((int)slot[0]);
        __syncthreads();
        if (p >= 64u + 512u) break;
        int h, bc, i;
        if (p < 64u) { const int r = p >> 5; i = p & 31; bc = qi >> 1; h = (qi & 1) == 0 ? (r == 0 ? 7 : 4) : (r == 0 ? 6 : 5); }
        else { own = false; const unsigned g = p - 64u; h = 3 - (int)(g >> 7); bc = (int)((g >> 5) & 3u); i = (int)(g & 31u); }
        const int qblk = (i & 1) ? 15 - (i >> 1) : 16 + (i >> 1);
        const int b = bc >> 1, c = bc & 1;
        const float slope = exp2f(-(float)(h + 1));
        const float needC = 0.5f * twoB + 30.f + logf(2.f / (expf(slope) - 1.f));
        const int q0 = qblk * 256;
        const size_t row0 = (size_t)b * SEQ;
        const bf16* Qb = QKV + (row0 + q0) * LDQA + (h * 2 + c) * 128;
        const bf16* Kh = QKV + row0 * LDQA + 2048 + (h * 2 + c) * 128;
        const bf16* Vh = QKV + row0 * LDQA + 4096 + h * 256;
        bf16* Ob = OC + (row0 + q0) * LDOC + (h * 2 + c) * 256;
        att::ModA2 mod; mod.slopeS = slope * att::ISCALE; mod.qk0 = q0 + (F.tid >> 6) * 32 + (F.lane & 31) - 4 * (F.lane >> 5);
        att::attn_unit_dma_A<LDQA, LDQA, LDOC, att::ModA2>((const att::bf16*)Qb, (const att::bf16*)Kh, (const att::bf16*)Vh, (att::bf16*)Ob, q0, SEQ / 64, slope, needC, mod, ldsl + RING_OFF,
                                                          (volatile LAS float*)(ldsl + MISC_OFF) + 24);
    }
}
__device__ __forceinline__ void attnB_phase(const bf16* QKV, bf16* O, const float* rel_bias, LAS unsigned char* ldsl) {
    const Geo F = geo(); const int wid = F.tid >> 6, r32 = F.lane & 31, hi = F.lane >> 5;
    float* tbl = (float*)((char*)(ldsl + RING_OFF) + att::TBL2_OFF);
    for (int uidx = F.vcu; uidx < 1024; uidx += F.G) {
        const int qblk = uidx & 31, combo = uidx >> 5, h = combo & 15, b = combo >> 4;
        const int r0 = qblk * 4, lo = clampi(r0 - 4, 0, 120), hi_ = clampi(r0 - 1, 0, 120) + 8; const int NT = hi_ - lo;
        const size_t row0 = (size_t)b * SEQ;
        const bf16* Qb = QKV + (row0 + qblk * 256) * LDQA + h * 128;
        const bf16* Kh = QKV + (row0 + lo * 64) * LDQA + 2048 + h * 128;
        const bf16* Vh = QKV + (row0 + lo * 64) * LDQA + 4096 + h * 128;
        bf16* Ob = O + (row0 + qblk * 256) * LD2 + h * 128;
        for (int i = F.tid; i < att::TBL_FLOATS; i += NWAVES * 64) { const int j = i - 64; tbl[i] = (j >= 0 && j < 465) ? rel_bias[h * 465 + j] * att::ISCALE : 0.f; }
        const int pos = qblk * 256 + wid * 32 + r32, r = pos >> 6, c = pos & 63;
        att::ModB2 mod; mod.tbl = tbl; mod.r = r; mod.r_start = clampi(r - 4, 0, 120); mod.kr0 = lo; mod.tb0 = 64 + 4 * hi - c + 15; mod.kc0 = 4 * hi - clampi(c - 8, 0, 48);
        { const int pw = qblk * 256 + wid * 32; mod.rs_u = __builtin_amdgcn_readfirstlane(clampi((pw >> 6) - 4, 0, 120)); mod.cw0 = __builtin_amdgcn_readfirstlane(pw & 63); }
        att::attn_unit_dma<4, LDQA, LDQA, LD2, att::ModB2>((const att::bf16*)Qb, (const att::bf16*)Kh, (const att::bf16*)Vh, (att::bf16*)Ob, NT, mod, ldsl + RING_OFF);
    }
}
__device__ __forceinline__ void attnC_phase(const bf16* QKV, bf16* O, const float* sink, LAS unsigned char* ldsl) {
    const Geo F = geo(); const int wid = F.tid >> 6, r32 = F.lane & 31, hi = F.lane >> 5;
    for (int uidx = F.vcu; uidx < 1024; uidx += F.G) {
        const int qblk = uidx & 31, combo = uidx >> 5, h = combo & 15, b = combo >> 4, kv = h >> 2;
        const int q0 = qblk * 256, klo = q0 - 128 < 0 ? 0 : q0 - 128, khi = q0 + 384 > SEQ ? SEQ : q0 + 384, NT = (khi - klo) / 64;
        const size_t row0 = (size_t)b * SEQ;
        const bf16* Qb = QKV + (row0 + q0) * LDQC + h * 128;
        const bf16* Kh = QKV + (row0 + klo) * LDQC + 2048 + kv * 128;
        const bf16* Vh = QKV + (row0 + klo) * LDQC + 2560 + kv * 128;
        bf16* Ob = O + (row0 + q0) * LD2 + h * 128;
        att::ModC2 mod; mod.slopeS = exp2f(-0.5f * (float)(h + 1)) * att::ISCALE; mod.sinkS = sink[h] * att::ISCALE; mod.qk0 = q0 + wid * 32 + r32 - klo - 4 * hi; mod.qw0 = __builtin_amdgcn_readfirstlane(q0 + wid * 32 - klo);
        att::attn_unit_dma<4, LDQC, LDQC, LD2, att::ModC2>((const att::bf16*)Qb, (const att::bf16*)Kh, (const att::bf16*)Vh, (att::bf16*)Ob, NT, mod, ldsl + RING_OFF);
    }
}

__device__ __forceinline__ void ph_prologue(LAS unsigned char* lds) {
    const Geo F = geo();
    unsigned char* ws = tbl_ws(lds);
    bf16* const WGU = (bf16*)(ws + WS_WGU); bf16* const WDN = (bf16*)(ws + WS_WDN); bf16* const WQKV = (bf16*)(ws + WS_WQKV); bf16* const WO = (bf16*)(ws + WS_WO);
    LAS float* scr = (LAS float*)(lds + RING_OFF + F.wave * 16384);
    constexpr int IF = (DM / 64) * (DFF / 32);
    static_assert(IF == (DFF / 64) * (DM / 32), "item counts");
    for (int Li = 0; Li < DEPTH; ++Li) {
        const int L = DEPTH - 1 - Li;
        const int kind = L % 3, j = L / 3, nq = kind == 2 ? 3072 : 6144;
        const float* wqkv = kind == 0 ? tbl_in(lds, 10) + (size_t)j * DM * 6144 : tbl_in(lds, kind == 1 ? 19 : 24);
        const float* wo = kind == 0 ? tbl_in(lds, 18) + (size_t)j * DM * DM : tbl_in(lds, kind == 1 ? 23 : 28);
        const int IQ = (DM / 64) * (nq / 32), IO = (DM / 64) * (DM / 32), NIT = 6 * IF + IQ + IO;
        const size_t offF = (size_t)L * DM * DFF;
        bf16* gu1 = WGU + (size_t)(2 * L) * NGU * LD2; bf16* gu2 = gu1 + (size_t)NGU * LD2;
        bf16* dn1 = WDN + (size_t)(2 * L) * DM * LDF; bf16* dn2 = dn1 + (size_t)DM * LDF;
        for (int it = F.gw; it < NIT; it += F.NGW) {
            int r = NIT - 1 - it;
            if (r < IF) { p0_gu(tbl_in(lds, 2) + offF, tbl_in(lds, 1) + L * DM, gu1, 0, r, scr, F.lane); continue; } r -= IF;
            if (r < IF) { p0_gu(tbl_in(lds, 3) + offF, tbl_in(lds, 1) + L * DM, gu1, 1, r, scr, F.lane); continue; } r -= IF;
            if (r < IF) { p0_plain(tbl_in(lds, 4) + offF, nullptr, DFF, DM, dn1, r, scr, F.lane); continue; } r -= IF;
            if (r < IF) { p0_gu(tbl_in(lds, 7) + offF, tbl_in(lds, 6) + L * DM, gu2, 0, r, scr, F.lane); continue; } r -= IF;
            if (r < IF) { p0_gu(tbl_in(lds, 8) + offF, tbl_in(lds, 6) + L * DM, gu2, 1, r, scr, F.lane); continue; } r -= IF;
            if (r < IF) { p0_plain(tbl_in(lds, 9) + offF, nullptr, DFF, DM, dn2, r, scr, F.lane); continue; } r -= IF;
            if (r < IQ) { p0_plain(wqkv, tbl_in(lds, 5) + L * DM, DM, nq, WQKV + (size_t)L * 6144 * LD2, r, scr, F.lane); continue; } r -= IQ;
            p0_plain(wo, nullptr, DM, DM, WO + (size_t)L * DM * LD2, r, scr, F.lane);
        }
    }
    xcast_phase(tbl_in(lds, 0), (bf16*)(ws + WS_H), (float*)(ws + WS_ROWSS));
}
__device__ __forceinline__ int ver_ffn(int s) { return s + ((s + 1) >> 1); }
__device__ __forceinline__ float* rowss_of(unsigned char* ws, int v) { return (float*)(ws + WS_ROWSS) + (size_t)v * M * 32; }
__device__ __forceinline__ void ph_gemm_gu(LAS unsigned char* lds, int s) {
    unsigned char* ws = tbl_ws(lds); const int G = gridDim.x;
    pg8::Gemm g{(const bf16*)(ws + WS_H), (const bf16*)(ws + WS_WGU) + (size_t)s * NGU * LD2, M, NGU, DM, LD2, LD2}; pg8::StaticOrder S; S.init(M, NGU, G, (int)blockIdx.x);
    volatile LAS int* tag = (volatile LAS int*)(lds + MISC_OFF) + 20; if (threadIdx.x == 0) *tag = -1;
    pg8::EpiSwiGLU E{(bf16*)(ws + WS_ACT), LDF, pg8::RstdPanel{rowss_of(ws, ver_ffn(s)), (LAS float*)(lds + RSTD_OFF), tag}};
    pg8::gemm_phase<pg8::EpiSwiGLU, pg8::StaticOrder, true, true>(lds + RING_OFF, g, S, E);
}
__device__ __forceinline__ void ph_gemm_down(LAS unsigned char* lds, int s) {
    unsigned char* ws = tbl_ws(lds); const int G = gridDim.x;
    pg8::Gemm g{(const bf16*)(ws + WS_ACT), (const bf16*)(ws + WS_WDN) + (size_t)s * DM * LDF, M, DM, DFF, LDF, LDF}; pg8::StaticOrder S; S.init(M, DM, G, (int)blockIdx.x);
    const bool last = s == 2 * DEPTH - 1;
    pg8::EpiResid E{s == 0 ? tbl_in(lds, 0) : nullptr, (const bf16*)(ws + WS_H), last ? nullptr : (bf16*)(ws + WS_H), last ? (float*)tbl_in(lds, I_OUT) : nullptr, last ? nullptr : rowss_of(ws, ver_ffn(s) + 1), LD2, DM, 0.5f};
    pg8::gemm_phase<pg8::EpiResid, pg8::StaticOrder, true, true>(lds + RING_OFF, g, S, E);
}
__device__ __forceinline__ void ph_gemm_qkv(LAS unsigned char* lds, int L) {
    unsigned char* ws = tbl_ws(lds); const int G = gridDim.x; const int nq = (L % 3) == 2 ? 3072 : 6144;
    pg8::Gemm g{(const bf16*)(ws + WS_H), (const bf16*)(ws + WS_WQKV) + (size_t)L * 6144 * LD2, M, nq, DM, LD2, LD2}; pg8::StaticOrder S; S.init(M, nq, G, (int)blockIdx.x);
    const int kind = L % 3, j = L / 3;
    const float* gq = tbl_in(lds, kind == 0 ? 11 : (kind == 1 ? 20 : 25)) + (kind == 0 ? j * HD : 0);
    const float* gk = tbl_in(lds, kind == 0 ? 12 : (kind == 1 ? 21 : 26)) + (kind == 0 ? j * HD : 0);
    volatile LAS int* tag = (volatile LAS int*)(lds + MISC_OFF) + 20; if (threadIdx.x == 0) *tag = -1;
    pg8::EpiQKV E{(bf16*)(ws + WS_QKV), nq + 128, pg8::RstdPanel{rowss_of(ws, 3 * L + 1), (LAS float*)(lds + RSTD_OFF), tag}, gq, gk, kind == 2 ? 4 : 16, (LAS float*)(lds + QKN_OFF)};
    pg8::gemm_phase<pg8::EpiQKV, pg8::StaticOrder, true, true>(lds + RING_OFF, g, S, E);
}
__device__ __forceinline__ void ph_gemm_wo(LAS unsigned char* lds, int L) {
    unsigned char* ws = tbl_ws(lds); const int G = gridDim.x;
    pg8::Gemm g{(const bf16*)(ws + WS_O), (const bf16*)(ws + WS_WO) + (size_t)L * DM * LD2, M, DM, DM, LD2, LD2}; pg8::StaticOrder S; S.init(M, DM, G, (int)blockIdx.x);
    pg8::EpiResid E{nullptr, (const bf16*)(ws + WS_H), (bf16*)(ws + WS_H), nullptr, rowss_of(ws, 3 * L + 2), LD2, DM, 1.0f};
    pg8::gemm_phase<pg8::EpiResid, pg8::StaticOrder, true, true>(lds + RING_OFF, g, S, E);
}
__device__ __forceinline__ void ph_combineA(LAS unsigned char* lds, int L) {
    unsigned char* ws = tbl_ws(lds); const int j = L / 3, lane = threadIdx.x & 63;
    const float lambda_init = 0.8f - 0.6f * expf(-0.3f * (float)L);
    const float* lq1 = tbl_in(lds, 13) + j * HD; const float* lk1 = tbl_in(lds, 14) + j * HD; const float* lq2 = tbl_in(lds, 15) + j * HD; const float* lk2 = tbl_in(lds, 16) + j * HD;
    const float s1 = wave_sum(lq1[lane] * lk1[lane] + lq1[lane + 64] * lk1[lane + 64]);
    const float s2 = wave_sum(lq2[lane] * lk2[lane] + lq2[lane + 64] * lk2[lane + 64]);
    const float lam = expf(s1) - expf(s2) + lambda_init;
    combineA_phase((const bf16*)(ws + WS_OC), (bf16*)(ws + WS_O), lam, 1.0f - lambda_init, tbl_in(lds, 17) + j * 256);
}

struct Args { const float* in[29]; float* out; unsigned char* ws; };
__global__ void __launch_bounds__(NWAVES * 64, 2) fwd(Args args) {
    extern __shared__ __attribute__((aligned(16))) unsigned char lds_raw[];
    LAS unsigned char* lds = (LAS unsigned char*)lds_raw;
    {   const int tid = threadIdx.x;
        for (int u = tid; u < (LDS_BYTES - LDSCTL_OFF) / 4; u += NWAVES * 64) ((LAS unsigned*)(lds + LDSCTL_OFF))[u] = 0u;
        __syncthreads();
        if (tid == 0) { LAS unsigned long long* t = (LAS unsigned long long*)(lds + PTR_OFF);
#pragma unroll
            for (int i = 0; i < 29; ++i) t[i] = (unsigned long long)args.in[i];
            t[I_OUT] = (unsigned long long)args.out; t[I_WS] = (unsigned long long)args.ws; }
        __syncthreads();
    }
    { volatile LAS unsigned* MISC = (volatile LAS unsigned*)(lds + MISC_OFF); (void)xcd_barrier_post((unsigned*)tbl_ws(lds) + CW_BAR, MISC + 8); }
#define GRID_BAR() do { XcdBarrier b_; b_.bar = (unsigned*)tbl_ws(lds) + CW_BAR; b_.x = xb_xcc_id(); b_.st = (volatile LAS unsigned*)(lds + MISC_OFF) + 8; xcd_barrier(b_); } while (0)

    ph_prologue(lds);
    GRID_BAR();
    for (int s = 0; s < 2 * DEPTH; ++s) {
        const int L = s >> 1;
        ph_gemm_gu(lds, s);
        GRID_BAR();
        ph_gemm_down(lds, s);
        if (s == 2 * DEPTH - 1) break;
        GRID_BAR();
        if ((s & 1) == 0) {
            const int kind = L % 3;
            ph_gemm_qkv(lds, L);
            GRID_BAR();
            if (kind == 0) {
#ifndef NO_A
                { unsigned char* ws = tbl_ws(lds); const int j_ = L / 3; attnA_phase((const bf16*)(ws + WS_QKV), (bf16*)(ws + WS_OC), tbl_in(lds, 11) + j_ * HD, tbl_in(lds, 12) + j_ * HD, (unsigned*)ws + CW_Q + j_ * 16 * 64, lds); }
#endif
                GRID_BAR();
                ph_combineA(lds, L);
            } else if (kind == 1) {
#ifndef NO_B
                { unsigned char* ws = tbl_ws(lds); attnB_phase((const bf16*)(ws + WS_QKV), (bf16*)(ws + WS_O), tbl_in(lds, 22), lds); }
#endif
            } else {
#ifndef NO_C
                { unsigned char* ws = tbl_ws(lds); attnC_phase((const bf16*)(ws + WS_QKV), (bf16*)(ws + WS_O), tbl_in(lds, 27), lds); }
#endif
            }
            GRID_BAR();
            ph_gemm_wo(lds, L);
            GRID_BAR();
        }
    }
}

extern "C" void kernel_launch(void* const* d_in, const int* in_sizes, int n_in, void* d_out, int out_size, void* d_ws, size_t ws_size, hipStream_t stream) {
    static int grid = 0;
    if (grid == 0) {
        if (n_in != 29 || in_sizes[0] != M * DM || out_size != M * DM || ws_size < WS_END) { fprintf(stderr, "kernel_launch: shape/workspace mismatch (n_in %d, ws %zu, need %zu); nothing launched\n", n_in, ws_size, (size_t)WS_END); grid = -1; return; }
        int dev = 0, cus = 0, per_cu = 0;
        if (hipGetDevice(&dev) != hipSuccess || hipDeviceGetAttribute(&cus, hipDeviceAttributeMultiprocessorCount, dev) != hipSuccess) { grid = -1; return; }
        if (hipFuncSetAttribute((const void*)fwd, hipFuncAttributeMaxDynamicSharedMemorySize, LDS_BYTES) != hipSuccess) { fprintf(stderr, "kernel_launch: hipFuncSetAttribute failed\n"); grid = -1; return; }
        if (hipOccupancyMaxActiveBlocksPerMultiprocessor(&per_cu, (const void*)fwd, NWAVES * 64, LDS_BYTES) != hipSuccess || per_cu < 1) fprintf(stderr, "kernel_launch: occupancy query reports %d\n", per_cu);
        (void)hipGetLastError();
        grid = cus;
    }
    if (grid < 0) return;
    if (hipMemsetAsync((char*)d_ws + WS_CTL, 0, CTL_ZERO_BYTES, stream) != hipSuccess) return;
    Args a{};
    for (int i = 0; i < 29; ++i) a.in[i] = (const float*)d_in[i];
    a.out = (float*)d_out; a.ws = (unsigned char*)d_ws;
    hipLaunchKernelGGL(fwd, dim3(grid), dim3(NWAVES * 64), LDS_BYTES, stream, a);
    const hipError_t le = hipPeekAtLastError();
    if (le != hipSuccess) fprintf(stderr, "kernel_launch: launch failed: %s\n", hipGetErrorName(le));
}
```
